# Optimizing an MI355X kernel written in HIP

```python
import math
import jax, jax.numpy as jnp
from jax import lax
import numpy as np

D_MODEL = 1024
BATCH = 1
SEQ = 16384
DEPTH = 4

CHUNK = 64
Q_BLOCK = 128
EPS = 1e-6
N_A_LAYERS = DEPTH // 2
N_B_LAYERS = DEPTH - N_A_LAYERS

A_HEADS = 6
A_HEAD_DIM = 128
A_WIDTH = A_HEADS * A_HEAD_DIM
CONV_K = 4

B_HEADS = 6
QK_NOPE = 128
QK_ROPE = 64
V_HEAD = 128
Q_LORA = 256
KV_LORA = 256
B_WIDTH = B_HEADS * V_HEAD
ROPE_THETA = 10000.0

N_MEM = 256
MEM_HEADS = 4
MEM_HEAD_DIM = 64
MEM_WIDTH = MEM_HEADS * MEM_HEAD_DIM

D_FF = 2816

MIX_WIDTH = A_WIDTH + MEM_WIDTH
A_IN = 4 * A_WIDTH + 2 * A_HEADS + MEM_WIDTH
B_IN = Q_LORA + MEM_WIDTH

kernel_name = "hybrid_gdn_mla_yoco_macaron"


def rms_norm(x, g):
    xf = x.astype(jnp.float32)
    y = xf * lax.rsqrt(jnp.mean(xf * xf, axis=-1, keepdims=True) + EPS)
    return (y * g.astype(jnp.float32)).astype(x.dtype)


def l2_norm(x):
    xf = x.astype(jnp.float32)
    return (xf * lax.rsqrt(jnp.sum(xf * xf, axis=-1, keepdims=True) + EPS)).astype(x.dtype)


def swiglu(x, w_gu, w_down):
    gate, up = jnp.split(x @ w_gu, 2, axis=-1)
    return (jax.nn.silu(gate) * up) @ w_down


def rope_tables(positions, dim):
    inv = ROPE_THETA ** (-jnp.arange(0, dim, 2, dtype=jnp.float32) / dim)
    ang = positions.astype(jnp.float32)[..., None] * inv
    return jnp.cos(ang), jnp.sin(ang)


def apply_rope(x, cos, sin):
    xf = x.astype(jnp.float32)
    x1, x2 = jnp.split(xf, 2, axis=-1)
    c, s = cos[:, :, None, :], sin[:, :, None, :]
    return jnp.concatenate([x1 * c - x2 * s, x1 * s + x2 * c], axis=-1).astype(x.dtype)


def causal_depthwise_conv(x, w):
    k = w.shape[0]
    return lax.conv_general_dilated(
        x, w[:, None, :].astype(x.dtype), window_strides=(1,), padding=[(k - 1, 0)],
        dimension_numbers=("NWC", "WIO", "NWC"), feature_group_count=x.shape[-1])


def chunked_gated_delta_rule(q, k, v, beta, g):
    b, s, h, dk = q.shape
    dv = v.shape[-1]
    n = s // CHUNK
    f32 = jnp.float32

    def chunks(t):
        return t.astype(f32).reshape(b, n, CHUNK, h, -1).transpose(0, 3, 1, 2, 4)

    q, k, v = chunks(q), chunks(k), chunks(v)
    beta = chunks(beta[..., None])[..., 0]
    g_cum = jnp.cumsum(chunks(g[..., None])[..., 0], axis=-1)
    causal = jnp.tril(jnp.ones((CHUNK, CHUNK), dtype=bool))
    strict = jnp.tril(jnp.ones((CHUNK, CHUNK), dtype=bool), -1)
    diff = g_cum[..., :, None] - g_cum[..., None, :]
    decay = jnp.where(causal, jnp.exp(jnp.where(causal, diff, 0.0)), 0.0)
    k_beta = k * beta[..., None]
    t_mat = jnp.where(strict, jnp.einsum("bhnid,bhnjd->bhnij", k_beta, k) * decay, 0.0) \
        + jnp.eye(CHUNK, dtype=f32)
    u = lax.linalg.triangular_solve(t_mat, v * beta[..., None], left_side=True,
                                    lower=True, unit_diagonal=True)
    w = lax.linalg.triangular_solve(t_mat, k_beta * jnp.exp(g_cum)[..., None], left_side=True,
                                    lower=True, unit_diagonal=True)
    qk = jnp.einsum("bhnid,bhnjd->bhnij", q, k) * decay
    g_last = g_cum[..., -1:]
    q_dec = q * jnp.exp(g_cum)[..., None]
    k_dec = k * jnp.exp(g_last - g_cum)[..., None]
    chunk_decay = jnp.exp(g_last[..., 0])
    xs = tuple(jnp.moveaxis(t, 2, 0) for t in (q_dec, k_dec, w, u, qk, chunk_decay))

    def step(state, inp):
        q_c, k_c, w_c, u_c, qk_c, d_c = inp
        v_new = u_c - jnp.einsum("bhcd,bhde->bhce", w_c, state)
        out = jnp.einsum("bhcd,bhde->bhce", q_c, state) + jnp.einsum("bhij,bhje->bhie", qk_c, v_new)
        state = state * d_c[..., None, None] + jnp.einsum("bhcd,bhce->bhde", k_c, v_new)
        return state, out

    _, o = lax.scan(step, jnp.zeros((b, h, dk, dv), f32), xs)
    return o.transpose(1, 0, 3, 2, 4).reshape(b, s, h, dv)


def gated_deltanet(qkv, gate, b_raw, a_raw, conv_w, A_log, dt_bias, out_gain):
    b, s, _ = qkv.shape
    qkv = jax.nn.silu(causal_depthwise_conv(qkv, conv_w))
    q, k, v = (t.reshape(b, s, A_HEADS, A_HEAD_DIM) for t in jnp.split(qkv, 3, axis=-1))
    q = l2_norm(q) * A_HEAD_DIM ** -0.5
    k = l2_norm(k)
    beta = jax.nn.sigmoid(b_raw.astype(jnp.float32))
    g = -jnp.exp(A_log.astype(jnp.float32)) * jax.nn.softplus(
        a_raw.astype(jnp.float32) + dt_bias.astype(jnp.float32))
    o = chunked_gated_delta_rule(q, k, v, beta, g).astype(qkv.dtype)
    o = rms_norm(o, out_gain) * jax.nn.silu(gate.reshape(b, s, A_HEADS, A_HEAD_DIM))
    return o.reshape(b, s, A_WIDTH)


def mla_attention(q_nope, q_rope, k_nope, k_rope, v):
    b, s, h, _ = q_nope.shape
    nb = s // Q_BLOCK
    scale = (QK_NOPE + QK_ROPE) ** -0.5
    key_chunk = jnp.arange(s) // CHUNK
    qn = q_nope.reshape(b, nb, Q_BLOCK, h, QK_NOPE).swapaxes(0, 1)
    qr = q_rope.reshape(b, nb, Q_BLOCK, h, QK_ROPE).swapaxes(0, 1)

    def block(args):
        i, qn_b, qr_b = args
        sc = (jnp.einsum("bqhd,bkhd->bhqk", qn_b, k_nope)
              + jnp.einsum("bqhd,bkd->bhqk", qr_b, k_rope)).astype(jnp.float32) * scale
        q_chunk = (i * Q_BLOCK + jnp.arange(Q_BLOCK)) // CHUNK
        mask = key_chunk[None, :] <= q_chunk[:, None]
        p = jax.nn.softmax(jnp.where(mask, sc, -jnp.inf), axis=-1).astype(v.dtype)
        return jnp.einsum("bhqk,bkhd->bqhd", p, v)

    out = lax.map(block, (jnp.arange(nb), qn, qr))
    return out.swapaxes(0, 1).reshape(b, s, h * V_HEAD)


def memory_attention(q, mem_kv):
    b, s, _ = q.shape
    q = q.reshape(b, s, MEM_HEADS, MEM_HEAD_DIM)
    k, v = (t.reshape(b, N_MEM, MEM_HEADS, MEM_HEAD_DIM) for t in jnp.split(mem_kv, 2, axis=-1))
    sc = jnp.einsum("bqhd,bmhd->bhqm", q, k).astype(jnp.float32) * MEM_HEAD_DIM ** -0.5
    p = jax.nn.softmax(sc, axis=-1).astype(v.dtype)
    return jnp.einsum("bhqm,bmhd->bqhd", p, v).reshape(b, s, MEM_WIDTH)


def setup_inputs(seed: int = 0) -> dict:
    key = jax.random.key(seed)
    ks = iter(jax.random.split(key, 40))
    f32 = jnp.float32

    def dense(shape, fan_in):
        return jax.random.normal(next(ks), shape, f32) * fan_in ** -0.5

    def gain(shape):
        return 1.0 + 0.02 * jax.random.normal(next(ks), shape, f32)

    x = jax.random.normal(next(ks), (BATCH, SEQ, D_MODEL), f32)
    mem = jax.random.normal(next(ks), (BATCH, N_MEM, D_MODEL), f32)
    offset = jax.random.randint(next(ks), (BATCH, 1), 0, 64, dtype=jnp.int32) * CHUNK
    positions = (offset + jnp.arange(SEQ, dtype=jnp.int32)[None, :]).astype(jnp.int32)

    ffn1_norm = gain((DEPTH, D_MODEL))
    ffn1_w_gu = dense((DEPTH, D_MODEL, 2 * D_FF), D_MODEL)
    ffn1_w_down = dense((DEPTH, D_FF, D_MODEL), D_FF)
    mix_norm = gain((DEPTH, D_MODEL))
    ffn2_norm = gain((DEPTH, D_MODEL))
    ffn2_w_gu = dense((DEPTH, D_MODEL, 2 * D_FF), D_MODEL)
    ffn2_w_down = dense((DEPTH, D_FF, D_MODEL), D_FF)
    w_out = dense((DEPTH, MIX_WIDTH, D_MODEL), MIX_WIDTH)
    mem_norm = gain((D_MODEL,))
    w_mem_kv = dense((DEPTH, D_MODEL, 2 * MEM_WIDTH), D_MODEL)

    a_w_in = dense((N_A_LAYERS, D_MODEL, A_IN), D_MODEL)
    a_conv = dense((N_A_LAYERS, CONV_K, 3 * A_WIDTH), CONV_K)
    a_A_log = jnp.log(jax.random.uniform(next(ks), (N_A_LAYERS, A_HEADS), f32, 1.0, 16.0))
    dt = jnp.exp(jax.random.uniform(next(ks), (N_A_LAYERS, A_HEADS), f32,
                                    math.log(1e-3), math.log(1e-1)))
    a_dt_bias = dt + jnp.log(-jnp.expm1(-dt))
    a_out_norm = gain((N_A_LAYERS, A_HEAD_DIM))

    b_w_in = dense((N_B_LAYERS, D_MODEL, B_IN), D_MODEL)
    b_q_norm = gain((N_B_LAYERS, Q_LORA))
    b_w_uq = dense((N_B_LAYERS, Q_LORA, B_HEADS * (QK_NOPE + QK_ROPE)), Q_LORA)

    kv_in_norm = gain((D_MODEL,))
    w_dkv = dense((D_MODEL, KV_LORA + QK_ROPE), D_MODEL)
    kv_lat_norm = gain((KV_LORA,))
    w_ukv = dense((KV_LORA, B_HEADS * (QK_NOPE + V_HEAD)), KV_LORA)
    final_norm = gain((D_MODEL,))

    return {"x": x, "mem": mem, "positions": positions,
            "ffn1_norm": ffn1_norm, "ffn1_w_gu": ffn1_w_gu, "ffn1_w_down": ffn1_w_down,
            "mix_norm": mix_norm,
            "ffn2_norm": ffn2_norm, "ffn2_w_gu": ffn2_w_gu, "ffn2_w_down": ffn2_w_down,
            "w_out": w_out, "mem_norm": mem_norm, "w_mem_kv": w_mem_kv,
            "a_w_in": a_w_in, "a_conv": a_conv, "a_A_log": a_A_log, "a_dt_bias": a_dt_bias,
            "a_out_norm": a_out_norm,
            "b_w_in": b_w_in, "b_q_norm": b_q_norm, "b_w_uq": b_w_uq,
            "kv_in_norm": kv_in_norm, "w_dkv": w_dkv, "kv_lat_norm": kv_lat_norm, "w_ukv": w_ukv,
            "final_norm": final_norm}


def reference(x, mem, positions, ffn1_norm, ffn1_w_gu, ffn1_w_down, mix_norm,
              ffn2_norm, ffn2_w_gu, ffn2_w_down, w_out, mem_norm, w_mem_kv,
              a_w_in, a_conv, a_A_log, a_dt_bias, a_out_norm,
              b_w_in, b_q_norm, b_w_uq, kv_in_norm, w_dkv, kv_lat_norm, w_ukv, final_norm):
    b, s, _ = x.shape
    mem_n = rms_norm(mem, mem_norm)
    cos, sin = rope_tables(positions, QK_ROPE)

    for i in range(N_A_LAYERS):
        l = i
        x = x + 0.5 * swiglu(rms_norm(x, ffn1_norm[l]), ffn1_w_gu[l], ffn1_w_down[l])
        h = rms_norm(x, mix_norm[l]) @ a_w_in[i]
        qkv, gate, b_raw, a_raw, q_mem = jnp.split(
            h, [3 * A_WIDTH, 4 * A_WIDTH, 4 * A_WIDTH + A_HEADS, 4 * A_WIDTH + 2 * A_HEADS], axis=-1)
        o_a = gated_deltanet(qkv, gate, b_raw, a_raw, a_conv[i], a_A_log[i], a_dt_bias[i], a_out_norm[i])
        o_m = memory_attention(q_mem, mem_n @ w_mem_kv[l])
        x = x + jnp.concatenate([o_a, o_m], axis=-1) @ w_out[l]
        x = x + 0.5 * swiglu(rms_norm(x, ffn2_norm[l]), ffn2_w_gu[l], ffn2_w_down[l])

    ckr = rms_norm(x, kv_in_norm) @ w_dkv
    c_kv = rms_norm(ckr[..., :KV_LORA], kv_lat_norm)
    k_rope = apply_rope(ckr[..., None, KV_LORA:], cos, sin)[:, :, 0]
    k_nope, v_mla = jnp.split((c_kv @ w_ukv).reshape(b, s, B_HEADS, QK_NOPE + V_HEAD), [QK_NOPE], axis=-1)

    for j in range(N_B_LAYERS):
        l = N_A_LAYERS + j
        x = x + 0.5 * swiglu(rms_norm(x, ffn1_norm[l]), ffn1_w_gu[l], ffn1_w_down[l])
        h = rms_norm(x, mix_norm[l]) @ b_w_in[j]
        cq, q_mem = jnp.split(h, [Q_LORA], axis=-1)
        q = (rms_norm(cq, b_q_norm[j]) @ b_w_uq[j]).reshape(b, s, B_HEADS, QK_NOPE + QK_ROPE)
        q_nope, q_rope = jnp.split(q, [QK_NOPE], axis=-1)
        q_rope = apply_rope(q_rope, cos, sin)
        o_b = mla_attention(q_nope, q_rope, k_nope, k_rope, v_mla)
        o_m = memory_attention(q_mem, mem_n @ w_mem_kv[l])
        x = x + jnp.concatenate([o_b, o_m], axis=-1) @ w_out[l]
        x = x + 0.5 * swiglu(rms_norm(x, ffn2_norm[l]), ffn2_w_gu[l], ffn2_w_down[l])

    return rms_norm(x, final_norm)
```

```cpp
#include <hip/hip_runtime.h>
#include <hip/hip_cooperative_groups.h>
#include <cstdio>
#include <cstdint>
#include <cmath>
namespace cg = cooperative_groups;
namespace pg8 {
#define PG8_LAS __attribute__((address_space(3)))
typedef unsigned short bf16_t;
typedef short bf16x8 __attribute__((ext_vector_type(8)));
typedef float f32x4 __attribute__((ext_vector_type(4)));
typedef unsigned u32x4 __attribute__((ext_vector_type(4)));
constexpr int BM = 256, BK = 64, HALF = 128, HTB = HALF * BK * 2  , STAGE_BYTES = 8 * HTB, NXCD = 8, WGM = 8;

__host__ __device__ __forceinline__ int lds_byte(int r, int c) { const int st = (r >> 4) * 2 + (c >> 5), rr = r & 15, cc = c & 31, ob = rr * 64 + cc * 2; return st * 1024 + (ob ^ (((ob >> 9) & 1) << 5)); }
__host__ __device__ __forceinline__ void stage_rc(int b, int& R, int& C) { const int st = b / 1024, sb = b % 1024, swz = sb ^ (((sb >> 9) & 1) << 5); R = (st >> 1) * 16 + swz / 64; C = (st & 1) * 32 + (swz % 64) / 2; }
__host__ __device__ __forceinline__ int perm32(int rho) { const int n = rho >> 4, i = rho & 15; return 8 * (i >> 2) + 4 * n + (i & 3); }

struct Unit { int pm, pn; };
struct Gemm { const bf16_t* A; const bf16_t* Bt; int M, N, K; };

struct StaticOrder {
    int nM, nN, nwg, G, c;
    __host__ __device__ void init(int M, int N, int G_, int c_) { nM = M / BM; nN = N / BM; nwg = nM * nN; G = G_; c = c_; }
    __host__ __device__ bool next(int i, Unit& u) const {
        const long L = (long)i * G + c; if (L >= nwg) return false;
        int wgid = (int)L; { const int q = nwg / NXCD, r = nwg % NXCD, xcd = wgid % NXCD, off = wgid / NXCD; wgid = (xcd < r ? xcd * (q + 1) : r * (q + 1) + (xcd - r) * q) + off; }
        const int nig = WGM * nN, gid = wgid / nig, fm = gid * WGM, gsz = (nM - fm) < WGM ? (nM - fm) : WGM;
        u.pm = fm + ((wgid % nig) % gsz); u.pn = (wgid % nig) / gsz; return true;
    }
    __device__ __forceinline__ void a_ready(const Unit&) const {}
    __device__ __forceinline__ void done(const Unit&) const {}
};

__device__ __forceinline__ unsigned cvt_pk_bf16(float lo, float hi) { unsigned r; asm volatile("v_cvt_pk_bf16_f32 %0, %1, %2" : "=v"(r) : "v"(lo), "v"(hi)); return r; }
typedef float f32x2 __attribute__((ext_vector_type(2)));
template <class Epi, class Sched, bool ALIGN_EPI = false, bool SP2 = false>
__device__ __forceinline__ void gemm_phase(PG8_LAS unsigned char* lds, const Gemm g, const Sched& S, const Epi& E) {
    int tid_o = threadIdx.x; asm volatile("" : "+v"(tid_o)); const int tid = tid_o, wid = __builtin_amdgcn_readfirstlane(tid >> 6), lane = tid & 63, wr = wid >> 2, wc = wid & 3, fr = lane & 15, fq = lane >> 4;
    const int K = g.K, nt = K / BK;
    unsigned voffA[2], voffB[2];
#pragma unroll
    for (int i = 0; i < 2; ++i) { int R, C; stage_rc(tid * 16 + i * 8192, R, C); const int Rb = Epi::PERM ? ((R & ~31) + perm32(R & 31)) : R;
        voffA[i] = (unsigned)(R * K + C) * 2u; voffB[i] = (unsigned)(Rb * K + C) * 2u; }
    const size_t kstep = (size_t)(BK * 2);
    const size_t hstep = (size_t)HALF * K * 2;
    const size_t tstep = 2 * hstep;
    const unsigned ldsw = (unsigned)wid * 1024u;
    const int aoff = lds_byte(wr * 64 + fr, fq * 8), boff = lds_byte(wc * 32 + fr, fq * 8);
#define PG8_SA(b, h) (((b) * 2 + (h)) * HTB)
#define PG8_SB(b, h) ((4 + (b) * 2 + (h)) * HTB)
#define PG8_STAGE(bufoff, gbase, voff) do { _Pragma("unroll") for (int _i = 0; _i < 2; ++_i) \
        __builtin_amdgcn_global_load_lds((const unsigned*)((const char*)(gbase) + (voff)[_i]), (PG8_LAS unsigned*)(lds + (bufoff) + ldsw + _i * 8192), 16, 0, 0); } while (0)
#define PG8_LDA(dst, b, h) do { _Pragma("unroll") for (int m = 0; m < 4; ++m) _Pragma("unroll") for (int k = 0; k < 2; ++k) dst[m][k] = *(const PG8_LAS bf16x8*)(lds + PG8_SA(b, h) + aoff + m * 2048 + k * 1024); } while (0)
#define PG8_LDB(dst, b, h) do { _Pragma("unroll") for (int n = 0; n < 2; ++n) _Pragma("unroll") for (int k = 0; k < 2; ++k) dst[n][k] = *(const PG8_LAS bf16x8*)(lds + PG8_SB(b, h) + boff + n * 2048 + k * 1024); } while (0)
#define PG8_MMA(ai, bj, At, Bt) do { __builtin_amdgcn_s_setprio(1); _Pragma("unroll") for (int m = 0; m < 4; ++m) _Pragma("unroll") for (int n = 0; n < 2; ++n) _Pragma("unroll") for (int k = 0; k < 2; ++k) \
        acc[ai][bj][m][n] = __builtin_amdgcn_mfma_f32_16x16x32_bf16(Bt[n][k], At[m][k], acc[ai][bj][m][n], 0, 0, 0); __builtin_amdgcn_s_setprio(0); } while (0)
#define PG8_WAIT_V(n) asm volatile("s_waitcnt vmcnt(" #n ")" ::: "memory")
#define PG8_WAIT_L(n) asm volatile("s_waitcnt lgkmcnt(" #n ")" ::: "memory")
#define PG8_BAR __builtin_amdgcn_s_barrier()
#define PG8_SCHED __builtin_amdgcn_sched_barrier(0)
    Unit cur, nxt; int ui = 0;
    if (!S.next(0, cur)) return;
    f32x4 acc[2][2][4][2];
#pragma unroll
    for (int a = 0; a < 2; ++a)
#pragma unroll
        for (int b = 0; b < 2; ++b)
#pragma unroll
            for (int m = 0; m < 4; ++m)
#pragma unroll
                for (int n = 0; n < 2; ++n) acc[a][b][m][n] = (f32x4){0.f, 0.f, 0.f, 0.f};
    bf16x8 At[4][2], B0[2][2], B1[2][2];
    const char* cA = (const char*)g.A + (size_t)cur.pm * tstep; const char* cB = (const char*)g.Bt + (size_t)cur.pn * tstep;
    S.a_ready(cur);
    if constexpr (SP2) {
        PG8_STAGE(PG8_SB(0, 0), cB, voffB); PG8_STAGE(PG8_SB(0, 1), cB + hstep, voffB); PG8_STAGE(PG8_SA(0, 0), cA, voffA); PG8_STAGE(PG8_SA(0, 1), cA + hstep, voffA);
        if (wr == 1) PG8_BAR;
        PG8_WAIT_V(2); PG8_BAR;
        PG8_STAGE(PG8_SB(1, 0), cB + kstep, voffB); PG8_STAGE(PG8_SA(1, 0), cA + kstep, voffA); PG8_STAGE(PG8_SB(1, 1), cB + hstep + kstep, voffB);
        PG8_WAIT_V(6); PG8_BAR;
    } else {
        PG8_STAGE(PG8_SB(0, 0), cB, voffB); PG8_STAGE(PG8_SA(0, 0), cA, voffA); PG8_STAGE(PG8_SB(0, 1), cB + hstep, voffB); PG8_STAGE(PG8_SA(0, 1), cA + hstep, voffA);
        if (wr == 1) PG8_BAR;
        PG8_WAIT_V(4); PG8_BAR;
        PG8_STAGE(PG8_SB(1, 0), cB + kstep, voffB); PG8_STAGE(PG8_SA(1, 0), cA + kstep, voffA); PG8_STAGE(PG8_SB(1, 1), cB + hstep + kstep, voffB);
        PG8_WAIT_V(6); PG8_BAR;
    }
    for (;;) {
        const bool has_next = S.next(ui + 1, nxt);
        const char* nA = has_next ? (const char*)g.A + (size_t)nxt.pm * tstep : cA; const char* nB = has_next ? (const char*)g.Bt + (size_t)nxt.pn * tstep : cB;
        for (int t = 0; t < nt; t += 2) {
            const bool last = (t == nt - 2);
            const char* a1 = cA + (size_t)(t + 1) * kstep;
            const char* a2 = last ? nA : cA + (size_t)(t + 2) * kstep; const char* b2 = last ? nB : cB + (size_t)(t + 2) * kstep;
            const char* a3 = a2 + kstep; const char* b3 = b2 + kstep;
            if (last && has_next) S.a_ready(nxt);
            if constexpr (SP2) {
            PG8_LDB(B0, 0, 0); PG8_LDB(B1, 0, 1); PG8_SCHED; PG8_LDA(At, 0, 0); PG8_STAGE(PG8_SA(1, 1), a1 + hstep, voffA);
            PG8_WAIT_V(8); PG8_WAIT_L(0); PG8_BAR; PG8_MMA(0, 0, At, B0); PG8_MMA(0, 1, At, B1); PG8_BAR; PG8_SCHED;
            PG8_LDA(At, 0, 1); PG8_STAGE(PG8_SB(0, 0), b2, voffB); PG8_STAGE(PG8_SB(0, 1), b2 + hstep, voffB); PG8_STAGE(PG8_SA(0, 0), a2, voffA);
            PG8_WAIT_V(8); PG8_WAIT_L(0); PG8_BAR; PG8_MMA(1, 0, At, B0); PG8_MMA(1, 1, At, B1); PG8_BAR; PG8_SCHED;
            PG8_LDB(B0, 1, 0); PG8_LDB(B1, 1, 1); PG8_SCHED; PG8_LDA(At, 1, 0); PG8_STAGE(PG8_SA(0, 1), a2 + hstep, voffA);
            PG8_WAIT_V(8); PG8_WAIT_L(0); PG8_BAR; PG8_MMA(0, 0, At, B0); PG8_MMA(0, 1, At, B1); PG8_BAR; PG8_SCHED;
            PG8_LDA(At, 1, 1); PG8_STAGE(PG8_SB(1, 0), b3, voffB); PG8_STAGE(PG8_SB(1, 1), b3 + hstep, voffB); PG8_STAGE(PG8_SA(1, 0), a3, voffA);
            PG8_WAIT_V(8); PG8_WAIT_L(0); PG8_BAR; PG8_MMA(1, 0, At, B0); PG8_MMA(1, 1, At, B1); PG8_BAR; PG8_SCHED;
            } else {
            PG8_LDB(B0, 0, 0); PG8_SCHED; PG8_LDA(At, 0, 0); PG8_STAGE(PG8_SA(1, 1), a1 + hstep, voffA);
            PG8_WAIT_L(8); PG8_BAR; PG8_WAIT_L(0); PG8_MMA(0, 0, At, B0); PG8_BAR; PG8_SCHED;
            PG8_LDB(B1, 0, 1); PG8_STAGE(PG8_SB(0, 0), b2, voffB);
            PG8_BAR; PG8_WAIT_L(0); PG8_MMA(0, 1, At, B1); PG8_BAR;
            PG8_LDA(At, 0, 1); PG8_STAGE(PG8_SA(0, 0), a2, voffA);
            PG8_BAR; PG8_WAIT_L(0); PG8_MMA(1, 0, At, B0); PG8_BAR; PG8_SCHED;
            PG8_STAGE(PG8_SB(0, 1), b2 + hstep, voffB);
            PG8_WAIT_V(6); PG8_BAR; PG8_MMA(1, 1, At, B1); PG8_BAR;
            PG8_LDB(B0, 1, 0); PG8_SCHED; PG8_LDA(At, 1, 0); PG8_STAGE(PG8_SA(0, 1), a2 + hstep, voffA);
            PG8_WAIT_L(8); PG8_BAR; PG8_WAIT_L(0); PG8_MMA(0, 0, At, B0); PG8_BAR; PG8_SCHED;
            PG8_LDB(B1, 1, 1); PG8_STAGE(PG8_SB(1, 0), b3, voffB);
            PG8_BAR; PG8_WAIT_L(0); PG8_MMA(0, 1, At, B1); PG8_BAR;
            PG8_LDA(At, 1, 1); PG8_STAGE(PG8_SA(1, 0), a3, voffA);
            PG8_BAR; PG8_WAIT_L(0); PG8_MMA(1, 0, At, B0); PG8_BAR; PG8_SCHED;
            PG8_STAGE(PG8_SB(1, 1), b3 + hstep, voffB);
            PG8_WAIT_V(6); PG8_BAR; PG8_MMA(1, 1, At, B1); PG8_BAR;
            }
        }
        if constexpr (ALIGN_EPI) { if (wr == 0) PG8_BAR; }
        if constexpr (!Epi::AFTER_DRAIN) { E(acc, cur, wr, wc, fr, fq); S.done(cur); }
        if (!has_next) break;
#pragma unroll
        for (int a = 0; a < 2; ++a)
#pragma unroll
            for (int b = 0; b < 2; ++b)
#pragma unroll
                for (int m = 0; m < 4; ++m)
#pragma unroll
                    for (int n = 0; n < 2; ++n) acc[a][b][m][n] = (f32x4){0.f, 0.f, 0.f, 0.f};
        cur = nxt; cA = nA; cB = nB; ++ui;
        if constexpr (ALIGN_EPI) { if (wr == 1) PG8_BAR; }
    }
    PG8_WAIT_V(0);
    if constexpr (!ALIGN_EPI) { if (wr == 0) PG8_BAR; }
    PG8_BAR;
    if constexpr (Epi::AFTER_DRAIN) { E.fused(acc, cur, wr, wc, fr, fq, lds, wid, lane); S.done(cur); }
#undef PG8_SA
#undef PG8_SB
#undef PG8_STAGE
#undef PG8_LDA
#undef PG8_LDB
#undef PG8_MMA
#undef PG8_WAIT_V
#undef PG8_WAIT_L
#undef PG8_BAR
#undef PG8_SCHED
}
}

#define LAS __attribute__((address_space(3)))
using pg8::bf16_t; using pg8::bf16x8; using pg8::f32x4; using pg8::u32x4;
typedef unsigned u32x2 __attribute__((ext_vector_type(2)));
typedef LAS unsigned char* ldsp;

constexpr int S_ = 16384, D_ = 1024, DFF = 2816, NGU = 5632;
constexpr int LDHA = 3584, QMA = 3328, LDHB = 512, QMB = 256;
constexpr int NTHREADS = 512, NW = 8;
constexpr int LDS_BYTES = 147456, XB_LDS_OFF = 147200;
constexpr float EPS = 1e-6f;

constexpr size_t MiB = 1u << 20;
constexpr size_t WS_CTL = 0, WS_TAB = 2048, WS_XBAR = 16384, CTL_ZERO_BYTES = 32768, WS_ROPE = 1 * MiB, WS_MEMN = 5 * MiB, WS_MEMK = 5 * MiB + 512 * 1024, WS_MEMVT = 5 * MiB + 640 * 1024;
constexpr size_t WS_DKVT = 6 * MiB, WS_UKT = 7 * MiB, WS_UVT = 7 * MiB + 384 * 1024;
constexpr size_t WS_W = 8 * MiB, WS_X = 54 * MiB, WS_XN = 118 * MiB, WS_KCAT = 150 * MiB, WS_VT = 186 * MiB;
constexpr size_t WS_HA = 150 * MiB, WS_NEGW = 262 * MiB, WS_QD = 286 * MiB, WS_KDT = 310 * MiB, WS_QK = 334 * MiB, WS_UT = 346 * MiB, WS_DCH = 370 * MiB;
constexpr size_t WS_H = 210 * MiB, WS_HB = 210 * MiB, WS_CQN = 226 * MiB, WS_QCAT = 234 * MiB;
constexpr size_t WS_MIX = 54 * MiB;
constexpr size_t WS_XG2 = 298 * MiB;
constexpr size_t WS_SSQ = 371 * MiB;
constexpr size_t WS_SQQ = 384 * MiB;
constexpr size_t WS_END = 385 * MiB;
constexpr size_t WO_GU1 = 0, WO_D1 = 5767168, WO_GU2 = 8650752, WO_D2 = 14417920, WO_OUT = 17301504, WO_MKV = 18350080, WO_IN = 18874368, WO_UQ = 19398656;

#define GAS __attribute__((address_space(1)))
__device__ __forceinline__ const float* gptr(const float* const* slot) { const unsigned long long v = *(const unsigned long long*)slot; return (const float*)(GAS const float*)v; }
struct Params { const float* in[26]; float* out; unsigned char* ws; float invf[32]; };

typedef float f32x2_t __attribute__((ext_vector_type(2))); typedef __bf16 bf16x2_t __attribute__((ext_vector_type(2)));
__device__ __forceinline__ unsigned pk2(float lo, float hi) { f32x2_t v = {lo, hi}; bf16x2_t b = __builtin_convertvector(v, bf16x2_t); return __builtin_bit_cast(unsigned, b); }
__device__ __forceinline__ float bf2f(unsigned short b) { return __uint_as_float(((unsigned)b) << 16); }
__device__ __forceinline__ float bflo(unsigned w) { return __uint_as_float(w << 16); }
__device__ __forceinline__ float bfhi(unsigned w) { return __uint_as_float(w & 0xffff0000u); }
__device__ __forceinline__ float wave_sum(float v) {
#pragma unroll
    for (int o = 1; o < 64; o <<= 1) v += __shfl_xor(v, o);
    return v;
}
__device__ __forceinline__ f32x4 mma(bf16x8 x, bf16x8 y, f32x4 c) { return __builtin_amdgcn_mfma_f32_16x16x32_bf16(x, y, c, 0, 0, 0); }
__device__ __forceinline__ float silu_f(float v) { return v * __builtin_amdgcn_rcpf(1.f + __builtin_amdgcn_exp2f(v * -1.4426950408889634f)); }
__device__ __forceinline__ int swzA(int r, int ch) { return r * 256 + ((ch ^ (r & 15)) << 4); }
__device__ __forceinline__ int swzB(int r, int ch) { return r * 128 + ((ch ^ (r & 7)) << 4); }
__device__ __forceinline__ bf16x8 ldsfrag(ldsp p) { return *(LAS bf16x8*)p; }
__device__ __forceinline__ bf16x8 gfrag(const bf16_t* p) { return *(const bf16x8*)p; }
__device__ __forceinline__ bf16x8 pack8(f32x4 a, f32x4 b) { u32x4 w; w.x = pk2(a[0], a[1]); w.y = pk2(a[2], a[3]); w.z = pk2(b[0], b[1]); w.w = pk2(b[2], b[3]); return __builtin_bit_cast(bf16x8, w); }
__device__ __forceinline__ u32x2 pack4(f32x4 a) { u32x2 w; w.x = pk2(a[0], a[1]); w.y = pk2(a[2], a[3]); return w; }

__device__ __forceinline__ float row_rstd(const float* ssq, int row, int fq) {
    const f32x4 pv = *(const f32x4*)(ssq + (size_t)row * 16 + 4 * fq);
    float s = (pv[0] + pv[1]) + (pv[2] + pv[3]);
    s += __shfl_xor(s, 16); s += __shfl_xor(s, 32);
    return rsqrtf(s * (1.f / D_) + EPS);
}
__device__ __forceinline__ void row_rstd8(const float* ssq, int row0, int fq, float (&r8)[2][4]) {
    f32x4 pv[2][4];
#pragma unroll
    for (int ai = 0; ai < 2; ++ai)
#pragma unroll
        for (int m = 0; m < 4; ++m) pv[ai][m] = *(const f32x4*)(ssq + (size_t)(row0 + ai * 128 + m * 16) * 16 + 4 * fq);
#pragma unroll
    for (int ai = 0; ai < 2; ++ai)
#pragma unroll
        for (int m = 0; m < 4; ++m) { float s = (pv[ai][m][0] + pv[ai][m][1]) + (pv[ai][m][2] + pv[ai][m][3]);
            s += __shfl_xor(s, 16); s += __shfl_xor(s, 32); r8[ai][m] = rsqrtf(s * (1.f / D_) + EPS); }
}
struct EpiSwiglu {
    static constexpr bool PERM = true, AFTER_DRAIN = false; bf16_t* H; const float* ssq;
    __device__ __forceinline__ void operator()(const f32x4 (&acc)[2][2][4][2], const pg8::Unit& u, int wr, int wc, int fr, int fq) const {
        const int row0 = u.pm * 256 + wr * 64 + fr, col = u.pn * 128 + wc * 32 + 8 * fq;
        float r8[2][4]; row_rstd8(ssq, row0, fq, r8);
#pragma unroll
        for (int ai = 0; ai < 2; ++ai)
#pragma unroll
            for (int m = 0; m < 4; ++m) {
                const float r = r8[ai][m];
                const f32x4 g0 = acc[ai][0][m][0] * r, g1 = acc[ai][0][m][1] * r, u0 = acc[ai][1][m][0] * r, u1 = acc[ai][1][m][1] * r;
                u32x4 w;
                w.x = pk2(silu_f(g0[0]) * u0[0], silu_f(g0[1]) * u0[1]); w.y = pk2(silu_f(g0[2]) * u0[2], silu_f(g0[3]) * u0[3]);
                w.z = pk2(silu_f(g1[0]) * u1[0], silu_f(g1[1]) * u1[1]); w.w = pk2(silu_f(g1[2]) * u1[2], silu_f(g1[3]) * u1[3]);
                *(u32x4*)(H + (size_t)(row0 + ai * 128 + m * 16) * DFF + col) = w;
            }
    }
};
struct EpiResid {
    static constexpr bool PERM = false, AFTER_DRAIN = false; bf16_t* xb; float scale; float* ssq;
    __device__ __forceinline__ void operator()(const f32x4 (&acc)[2][2][4][2], const pg8::Unit& u, int wr, int wc, int fr, int fq) const {
        const int row0 = u.pm * 256 + wr * 64 + fr, col0 = u.pn * 256 + wc * 32 + 4 * fq;
#pragma unroll
        for (int ai = 0; ai < 2; ++ai)
#pragma unroll
            for (int m = 0; m < 4; ++m) {
                const int row = row0 + ai * 128 + m * 16;
                float sq = 0.f;
#pragma unroll
                for (int bj = 0; bj < 2; ++bj)
#pragma unroll
                    for (int n = 0; n < 2; ++n) {
                        const size_t off = (size_t)row * D_ + col0 + bj * 128 + n * 16;
                        const u32x2 b = *(const u32x2*)(xb + off);
                        const f32x4 a = acc[ai][bj][m][n];
                        u32x2 w; w.x = pk2(bflo(b.x) + a[0] * scale, bfhi(b.x) + a[1] * scale); w.y = pk2(bflo(b.y) + a[2] * scale, bfhi(b.y) + a[3] * scale);
                        *(u32x2*)(xb + off) = w;
                        const float y0 = bflo(w.x), y1 = bfhi(w.x), y2 = bflo(w.y), y3 = bfhi(w.y);
                        sq += (y0 * y0 + y1 * y1) + (y2 * y2 + y3 * y3);
                    }
                sq += __shfl_xor(sq, 16); sq += __shfl_xor(sq, 32);
                if (fq == 0) ssq[(size_t)row * 16 + u.pn * 4 + wc] = sq;
            }
    }
};
template <bool P> struct EpiStore {
    static constexpr bool PERM = P, AFTER_DRAIN = false; bf16_t* O; int ldc; const float* ssq;
    __device__ __forceinline__ void operator()(const f32x4 (&acc)[2][2][4][2], const pg8::Unit& u, int wr, int wc, int fr, int fq) const {
        const int row0 = u.pm * 256 + wr * 64 + fr, col0 = u.pn * 256 + wc * 32 + 8 * fq;
        float r8[2][4];
        if (ssq) row_rstd8(ssq, row0, fq, r8);
#pragma unroll
        for (int ai = 0; ai < 2; ++ai)
#pragma unroll
            for (int m = 0; m < 4; ++m) {
                const float r = ssq ? r8[ai][m] : 1.f;
#pragma unroll
                for (int bj = 0; bj < 2; ++bj) {
                    u32x4 w; const f32x4 a = acc[ai][bj][m][0] * r, b = acc[ai][bj][m][1] * r;
                    w.x = pk2(a[0], a[1]); w.y = pk2(a[2], a[3]); w.z = pk2(b[0], b[1]); w.w = pk2(b[2], b[3]);
                    *(u32x4*)(O + (size_t)(row0 + ai * 128 + m * 16) * ldc + col0 + bj * 128) = w;
                }
            }
    }
};
struct EpiInB {
    static constexpr bool PERM = true, AFTER_DRAIN = false; bf16_t* HB; bf16_t* CQ; const float* ssq; float* sqq;
    __device__ __forceinline__ void operator()(const f32x4 (&acc)[2][2][4][2], const pg8::Unit& u, int wr, int wc, int fr, int fq) const {
        const int row0 = u.pm * 256 + wr * 64 + fr, cw = wc * 32 + 8 * fq;
        float r8[2][4]; row_rstd8(ssq, row0, fq, r8);
#pragma unroll
        for (int ai = 0; ai < 2; ++ai)
#pragma unroll
            for (int m = 0; m < 4; ++m) {
                const int row = row0 + ai * 128 + m * 16;
                const float r = r8[ai][m];
                float sq = 0.f;
#pragma unroll
                for (int bj = 0; bj < 2; ++bj) {
                    u32x4 w; const f32x4 a = acc[ai][bj][m][0] * r, b = acc[ai][bj][m][1] * r;
                    w.x = pk2(a[0], a[1]); w.y = pk2(a[2], a[3]); w.z = pk2(b[0], b[1]); w.w = pk2(b[2], b[3]);
                    if (u.pn == 0) {
                        *(u32x4*)(CQ + (size_t)row * 256 + bj * 128 + cw) = w;
                        const float y0 = bflo(w.x), y1 = bfhi(w.x), y2 = bflo(w.y), y3 = bfhi(w.y), y4 = bflo(w.z), y5 = bfhi(w.z), y6 = bflo(w.w), y7 = bfhi(w.w);
                        sq += ((y0 * y0 + y1 * y1) + (y2 * y2 + y3 * y3)) + ((y4 * y4 + y5 * y5) + (y6 * y6 + y7 * y7));
                    } else *(u32x4*)(HB + (size_t)row * LDHB + 256 + bj * 128 + cw) = w;
                }
                if (u.pn == 0) { sq += __shfl_xor(sq, 16); sq += __shfl_xor(sq, 32); if (fq == 0) sqq[(size_t)row * 4 + wc] = sq; }
            }
    }
};
struct EpiKnope {
    static constexpr bool PERM = true, AFTER_DRAIN = false; bf16_t* K;
    __device__ __forceinline__ void operator()(const f32x4 (&acc)[2][2][4][2], const pg8::Unit& u, int wr, int wc, int fr, int fq) const {
        const int row0 = u.pm * 256 + wr * 64 + fr, d = wc * 32 + 8 * fq;
#pragma unroll
        for (int ai = 0; ai < 2; ++ai)
#pragma unroll
            for (int m = 0; m < 4; ++m)
#pragma unroll
                for (int bj = 0; bj < 2; ++bj) {
                    const int head = 2 * u.pn + bj;
                    u32x4 w; const f32x4 a = acc[ai][bj][m][0], b = acc[ai][bj][m][1];
                    w.x = pk2(a[0], a[1]); w.y = pk2(a[2], a[3]); w.z = pk2(b[0], b[1]); w.w = pk2(b[2], b[3]);
                    *(u32x4*)(K + ((size_t)head * S_ + row0 + ai * 128 + m * 16) * 192 + d) = w;
                }
    }
};
struct EpiQ {
    static constexpr bool PERM = true, AFTER_DRAIN = false; bf16_t* Q; const float2* tab; float qs; const float* sqq;
    __device__ __forceinline__ float rq(int row) const { const f32x4 s = *(const f32x4*)(sqq + (size_t)row * 4); return rsqrtf(((s[0] + s[1]) + (s[2] + s[3])) * (1.f / 256.f) + EPS) * qs; }
    __device__ __forceinline__ void operator()(const f32x4 (&acc)[2][2][4][2], const pg8::Unit& u, int wr, int wc, int fr, int fq) const {
        const int row0 = u.pm * 256 + wr * 64 + fr;
        if (u.pn < 3) {
            const int d = wc * 32 + 8 * fq;
#pragma unroll
            for (int ai = 0; ai < 2; ++ai)
#pragma unroll
                for (int m = 0; m < 4; ++m)
#pragma unroll
                    for (int bj = 0; bj < 2; ++bj) {
                        const int head = 2 * u.pn + bj;
                        u32x4 w; const f32x4 a = acc[ai][bj][m][0] * rq(row0 + ai * 128 + m * 16), b = acc[ai][bj][m][1] * rq(row0 + ai * 128 + m * 16);
                        w.x = pk2(a[0], a[1]); w.y = pk2(a[2], a[3]); w.z = pk2(b[0], b[1]); w.w = pk2(b[2], b[3]);
                        *(u32x4*)(Q + ((size_t)(row0 + ai * 128 + m * 16) * 6 + head) * 192 + d) = w;
                    }
        } else {
            const int head = 4 * (u.pn - 3) + wc;
            if (head < 6) {
#pragma unroll
                for (int ai = 0; ai < 2; ++ai)
#pragma unroll
                    for (int m = 0; m < 4; ++m) {
                        const int row = row0 + ai * 128 + m * 16;
                        float o1[8], o2[8]; const float qr = rq(row);
#pragma unroll
                        for (int n = 0; n < 2; ++n)
#pragma unroll
                            for (int j = 0; j < 4; ++j) {
                                const float2 cs = tab[(size_t)row * 32 + 8 * fq + 4 * n + j];
                                const float x1 = acc[ai][0][m][n][j], x2 = acc[ai][1][m][n][j];
                                o1[4 * n + j] = (x1 * cs.x - x2 * cs.y) * qr; o2[4 * n + j] = (x1 * cs.y + x2 * cs.x) * qr;
                            }
                        u32x4 w1, w2;
                        w1.x = pk2(o1[0], o1[1]); w1.y = pk2(o1[2], o1[3]); w1.z = pk2(o1[4], o1[5]); w1.w = pk2(o1[6], o1[7]);
                        w2.x = pk2(o2[0], o2[1]); w2.y = pk2(o2[2], o2[3]); w2.z = pk2(o2[4], o2[5]); w2.w = pk2(o2[6], o2[7]);
                        bf16_t* qp = Q + ((size_t)row * 6 + head) * 192 + 128 + 8 * fq;
                        *(u32x4*)qp = w1; *(u32x4*)(qp + 32) = w2;
                    }
            }
        }
    }
};

template <class Epi, bool ALIGN = true> __device__ __forceinline__ void run_gemm(ldsp lds, const bf16_t* A, const bf16_t* Bt, int M, int N, int K, int c, const Epi& E) {
    asm volatile("" : "+s"(M), "+s"(N), "+s"(K), "+s"(c));
    pg8::Gemm g{A, Bt, M, N, K}; pg8::StaticOrder S; S.init(M, N, (int)gridDim.x, c);
    pg8::gemm_phase<Epi, pg8::StaticOrder, ALIGN, true>(lds, g, S, E);
}

__device__ __forceinline__ int wmap(int map, int n, int nsrc) {
    switch (map) {
    case 0: return n < nsrc ? n : -1;
    case 1: { const int t = n >> 8, w = n & 255; return (w >> 7) * DFF + t * 128 + (w & 127); }
    case 2: { if (n < 768) return (n >> 7) * 192 + (n & 127);
              const int m = n - 768, t = m >> 8, w = m & 255, bj = w >> 7, cc = w & 127, head = 4 * t + (cc >> 5), jj = cc & 31;
              return head < 6 ? head * 192 + 128 + bj * 32 + jj : -1; }
    case 3: return n < 3084 ? n : (n >= QMA ? n - QMA + 3084 : -1);
    case 4: return (n >> 7) * 256 + (n & 127);
    default: return (n >> 7) * 256 + 128 + (n & 127);
    }
}
__device__ __forceinline__ void conv_job(const float* W, int K, int Nsrc, int Nout, int map, bf16_t* WT, LAS float* scr, int gw, int ngw, int lane, const float* gk = nullptr) {
    const int nblk = Nout / 32, nitems = (K / 64) * nblk;
    for (int it = gw; it < nitems; it += ngw) {
        const int kb = it / nblk, nb = it % nblk, k0 = 64 * kb, n0 = 32 * nb;
        const int sc = wmap(map, n0 + (lane & 31), Nsrc);
        float wv[32];
#pragma unroll
        for (int i = 0; i < 32; ++i) { const int kk = 2 * i + (lane >> 5); wv[i] = sc >= 0 ? W[(size_t)(k0 + kk) * Nsrc + sc] : 0.f; }
        if (gk) {
#pragma unroll
            for (int i = 0; i < 32; ++i) wv[i] *= gk[k0 + 2 * i + (lane >> 5)];
        }
#pragma unroll
        for (int i = 0; i < 32; ++i) { const int kk = 2 * i + (lane >> 5); scr[kk * 33 + (lane & 31)] = wv[i]; }
        asm volatile("s_waitcnt lgkmcnt(0)" ::: "memory");
        const int c = lane & 7;
#pragma unroll
        for (int j = 0; j < 4; ++j) { const int n = (lane >> 3) + 8 * j; const LAS float* s = scr + (8 * c) * 33 + n;
            u32x4 o; o.x = pk2(s[0 * 33], s[1 * 33]); o.y = pk2(s[2 * 33], s[3 * 33]); o.z = pk2(s[4 * 33], s[5 * 33]); o.w = pk2(s[6 * 33], s[7 * 33]);
            *(u32x4*)(WT + (size_t)(n0 + n) * K + k0 + 8 * c) = o; }
        asm volatile("s_waitcnt lgkmcnt(0)" ::: "memory");
    }
}
__device__ __forceinline__ void conv_group(const float* const* tin, unsigned char* wsb, int l, int group, ldsp lds, int gw, int ngw, int lane, int wid) {
    LAS float* scr = (LAS float*)(lds + wid * 16384);
    bf16_t* W = (bf16_t*)(wsb + WS_W);
    if (group == 0) {
        conv_job(gptr(tin + 4) + (size_t)l * D_ * NGU, D_, NGU, NGU, 1, W + WO_GU1, scr, gw, ngw, lane, gptr(tin + 3) + l * D_);
        conv_job(gptr(tin + 12) + (size_t)l * D_ * 512, D_, 512, 512, 0, W + WO_MKV, scr, gw, ngw, lane);
    } else if (group == 1) {
        conv_job(gptr(tin + 5) + (size_t)l * DFF * D_, DFF, D_, D_, 0, W + WO_D1, scr, gw, ngw, lane);
        if (l < 2) conv_job(gptr(tin + 13) + (size_t)l * D_ * 3340, D_, 3340, LDHA, 3, W + WO_IN, scr, gw, ngw, lane, gptr(tin + 6) + l * D_);
        else { conv_job(gptr(tin + 18) + (size_t)(l - 2) * D_ * 512, D_, 512, 512, 0, W + WO_IN, scr, gw, ngw, lane, gptr(tin + 6) + l * D_);
               conv_job(gptr(tin + 20) + (size_t)(l - 2) * 256 * 1152, 256, 1152, 1280, 2, W + WO_UQ, scr, gw, ngw, lane, gptr(tin + 19) + (l - 2) * 256); }
        conv_job(gptr(tin + 10) + (size_t)l * D_ * D_, D_, D_, D_, 0, W + WO_OUT, scr, gw, ngw, lane);
    } else {
        conv_job(gptr(tin + 8) + (size_t)l * D_ * NGU, D_, NGU, NGU, 1, W + WO_GU2, scr, gw, ngw, lane, gptr(tin + 7) + l * D_);
        conv_job(gptr(tin + 9) + (size_t)l * DFF * D_, DFF, D_, D_, 0, W + WO_D2, scr, gw, ngw, lane);
    }
}

__device__ __forceinline__ void rms_row_bf16(const float* xrow, const float* g, bf16_t* orow, int lane) {
    f32x4 v[4]; float s = 0.f;
#pragma unroll
    for (int j = 0; j < 4; ++j) { v[j] = *(const f32x4*)(xrow + 4 * lane + 256 * j); s += (v[j][0] * v[j][0] + v[j][1] * v[j][1]) + (v[j][2] * v[j][2] + v[j][3] * v[j][3]); }
    const float r = rsqrtf(wave_sum(s) * (1.f / D_) + EPS);
#pragma unroll
    for (int j = 0; j < 4; ++j) { const f32x4 gg = *(const f32x4*)(g + 4 * lane + 256 * j);
        u32x2 w; w.x = pk2(v[j][0] * r * gg[0], v[j][1] * r * gg[1]); w.y = pk2(v[j][2] * r * gg[2], v[j][3] * r * gg[3]);
        *(u32x2*)(orow + 4 * lane + 256 * j) = w; }
}
__device__ __forceinline__ void norm_rows(const float* x, const float* g, bf16_t* xn, int nrows, int gw, int ngw, int lane) {
    for (int m = gw; m < nrows; m += ngw) rms_row_bf16(x + (size_t)m * D_, g, xn + (size_t)m * D_, lane);
}

template <int I> struct SolveRow {
    static __device__ __forceinline__ void run(float (&t)[64], const float (&a)[64], float lanef) {
        SolveRow<I - 1>::run(t, a, lanef);
        float s0 = __builtin_amdgcn_fmed3f(1.f - fabsf(lanef - (float)I), 0.f, 1.f), s1 = 0.f, s2 = 0.f, s3 = 0.f;
        const int ai = __float_as_int(a[I]);
#pragma unroll
        for (int j = 0; j < I; ++j) {
            const float aj = __int_as_float(__builtin_amdgcn_readlane(ai, j));
            if ((j & 3) == 0) s0 -= aj * t[j]; else if ((j & 3) == 1) s1 -= aj * t[j]; else if ((j & 3) == 2) s2 -= aj * t[j]; else s3 -= aj * t[j];
        }
        t[I] = (s0 + s1) + (s2 + s3);
    }
};
template <> struct SolveRow<0> { static __device__ __forceinline__ void run(float (&)[64], const float (&)[64], float) {} };
constexpr int PL_AS = 0, PL_TINV = 16384, PL_GC = 24576, PL_BETA = 24832, PL_QS = 32768, PL_KS = 49152, PL_KTS = 65536, PL_VTS = 81920;
__device__ __forceinline__ void gdn_prep_unit(ldsp L, int u, const bf16_t* hA, const float* convw, float Aexp, float dtb,
                                             bf16_t* negw, bf16_t* qd, bf16_t* kdT, bf16_t* qk, bf16_t* uT, float* dch, int tid, int wid, int lane) {
    const int n = u / 6, h = u - 6 * n, t0 = 64 * n, fr = lane & 15, fq = lane >> 4;
    const int us = h * 256 + n;
    LAS float* GC = (LAS float*)(L + PL_GC); LAS float* BETA = (LAS float*)(L + PL_BETA); LAS float* AS = (LAS float*)(L + PL_AS);
    float beta, gc, glast;
    {
        const bf16_t* rowp = hA + (size_t)(t0 + lane) * LDHA;
        const float braw = bf2f(rowp[3072 + h]), araw = bf2f(rowp[3078 + h]);
        beta = 1.f / (1.f + __expf(-braw));
        const float xs = araw + dtb; const float sp = xs > 20.f ? xs : log1pf(__expf(xs));
        gc = -Aexp * sp;
#pragma unroll
        for (int o = 1; o < 64; o <<= 1) { const float t = __shfl_up(gc, o); if (lane >= o) gc += t; }
        glast = __shfl(gc, 63);
        if (wid == 0) { GC[lane] = gc; BETA[lane] = beta; }
    }
#pragma unroll
    for (int tt = 0; tt < 3; ++tt) {
        const int cb = tt * 768 + h * 128 + 2 * lane;
        float w0[4], w1[4];
#pragma unroll
        for (int k = 0; k < 4; ++k) { const float2 wv = *(const float2*)(convw + k * 2304 + cb); w0[k] = wv.x; w1[k] = wv.y; }
        float x0[11], x1[11];
#pragma unroll
        for (int r = 0; r < 11; ++r) { const int row = t0 + 8 * wid - 3 + r; unsigned v = 0u; if (row >= 0) v = *(const unsigned*)(hA + (size_t)row * LDHA + cb); x0[r] = bflo(v); x1[r] = bfhi(v); }
#pragma unroll
        for (int i = 0; i < 8; ++i) {
            float a0 = 0.f, a1 = 0.f;
#pragma unroll
            for (int k = 0; k < 4; ++k) { a0 += w0[k] * x0[i + k]; a1 += w1[k] * x1[i + k]; }
            a0 = silu_f(a0); a1 = silu_f(a1);
            const int il = 8 * wid + i;
            const float bi = __shfl(beta, il), gi = __shfl(gc, il);
            if (tt < 2) {
                const float ss = wave_sum(a0 * a0 + a1 * a1);
                float rn = rsqrtf(ss + EPS); if (tt == 0) rn *= 0.08838834764831845f;
                a0 *= rn; a1 *= rn;
                *(LAS unsigned*)(L + (tt == 0 ? PL_QS : PL_KS) + swzA(il, lane >> 2) + (lane & 3) * 4) = pk2(a0, a1);
                if (tt == 1) { const float sc = bi * __expf(gi); const unsigned w = pk2(a0 * sc, a1 * sc);
                    *(LAS bf16_t*)(L + PL_KTS + swzB(2 * lane, il >> 3) + (il & 7) * 2) = (bf16_t)(w & 0xffffu);
                    *(LAS bf16_t*)(L + PL_KTS + swzB(2 * lane + 1, il >> 3) + (il & 7) * 2) = (bf16_t)(w >> 16); }
            } else {
                const unsigned w = pk2(a0 * bi, a1 * bi);
                *(LAS bf16_t*)(L + PL_VTS + swzB(2 * lane, il >> 3) + (il & 7) * 2) = (bf16_t)(w & 0xffffu);
                *(LAS bf16_t*)(L + PL_VTS + swzB(2 * lane + 1, il >> 3) + (il & 7) * 2) = (bf16_t)(w >> 16);
            }
        }
    }
    __syncthreads();
#pragma unroll
    for (int pp = 0; pp < 2; ++pp) {
        const int pr = wid + 8 * pp, it = pr >> 2, jt = pr & 3;
        f32x4 accA = {0.f, 0.f, 0.f, 0.f}, accQ = {0.f, 0.f, 0.f, 0.f};
        if (jt <= it) {
#pragma unroll
            for (int s = 0; s < 4; ++s) {
                const bf16x8 X = ldsfrag(L + PL_KS + swzA(16 * jt + fr, 4 * s + fq));
                const bf16x8 Yk = ldsfrag(L + PL_KS + swzA(16 * it + fr, 4 * s + fq));
                const bf16x8 Yq = ldsfrag(L + PL_QS + swzA(16 * it + fr, 4 * s + fq));
                accA = mma(X, Yk, accA); accQ = mma(X, Yq, accQ);
            }
        }
        const int i = 16 * it + fr; const float gci = GC[i], bi = BETA[i];
        f32x4 av, qv;
#pragma unroll
        for (int r = 0; r < 4; ++r) { const int j = 16 * jt + 4 * fq + r; const float dec = __expf(gci - GC[j]);
            av[r] = (j < i) ? bi * accA[r] * dec : 0.f; qv[r] = (j <= i) ? accQ[r] * dec : 0.f; }
        if (jt <= it) *(LAS f32x4*)(AS + i * 64 + 16 * jt + 4 * fq) = av;
        *(u32x2*)(qk + (size_t)us * 4096 + i * 64 + 32 * (jt >> 1) + 8 * fq + 4 * (jt & 1)) = pack4(qv);
    }
    __syncthreads();
    if (wid == 0) {
        float t[64]; const float lanef = (float)lane;
        unsigned asb_ = (unsigned)(uintptr_t)(L + PL_AS); asm volatile("" : "+v"(asb_)); const ldsp asb = (ldsp)asb_;
#pragma unroll
        for (int i = 0; i < 64; ++i) t[i] = 0.f;
        t[0] = __builtin_amdgcn_fmed3f(1.f - fabsf(lanef), 0.f, 1.f);
        float arow[64];
#pragma unroll
        for (int i = 0; i < 64; ++i) arow[i] = *(LAS float*)(asb + (i * 64) * 4 + lane * 4);
        SolveRow<63>::run(t, arow, lanef);
#pragma unroll
        for (int i = 0; i < 64; ++i) *(LAS bf16_t*)(L + PL_TINV + swzB(i, lane >> 3) + (lane & 7) * 2) = (bf16_t)(pk2(t[i], 0.f) & 0xffffu);
        if (lane == 0) dch[us] = __expf(glast);
    } else {
        const int t7 = tid - 64;
        for (int it = t7; it < 1024; it += 448) {
            const int c = it >> 4, oc = it & 15, s = oc >> 2, fqq = oc & 3, d1 = 32 * s + 4 * fqq, d2 = d1 + 16;
            const u32x2 a = *(LAS u32x2*)(L + PL_QS + swzA(c, d1 >> 3) + (d1 & 7) * 2), b = *(LAS u32x2*)(L + PL_QS + swzA(c, d2 >> 3) + (d2 & 7) * 2);
            const float e = __expf(GC[c]);
            u32x4 w; w.x = pk2(bflo(a.x) * e, bfhi(a.x) * e); w.y = pk2(bflo(a.y) * e, bfhi(a.y) * e); w.z = pk2(bflo(b.x) * e, bfhi(b.x) * e); w.w = pk2(bflo(b.y) * e, bfhi(b.y) * e);
            *(u32x4*)(qd + (size_t)us * 8192 + c * 128 + 8 * oc) = w;
        }
        for (int it = t7; it < 1024; it += 448) {
            const int d = it >> 3, oc = it & 7, s = oc >> 2, fqq = oc & 3;
            float v[8];
#pragma unroll
            for (int a = 0; a < 2; ++a)
#pragma unroll
                for (int b = 0; b < 4; ++b) { const int c = 32 * s + 16 * a + 4 * fqq + b;
                    v[4 * a + b] = bf2f(*(LAS bf16_t*)(L + PL_KS + swzA(c, d >> 3) + (d & 7) * 2)) * __expf(glast - GC[c]); }
            u32x4 w; w.x = pk2(v[0], v[1]); w.y = pk2(v[2], v[3]); w.z = pk2(v[4], v[5]); w.w = pk2(v[6], v[7]);
            *(u32x4*)(kdT + (size_t)us * 8192 + d * 64 + 8 * oc) = w;
        }
    }
    __syncthreads();
    {
        const int ct = wid >> 1;
        bf16x8 yt[2];
#pragma unroll
        for (int s2 = 0; s2 < 2; ++s2) yt[s2] = ldsfrag(L + PL_TINV + swzB(16 * ct + fr, 4 * s2 + fq));
#pragma unroll
        for (int q = 0; q < 4; ++q) {
            const int dt = 4 * (wid & 1) + q; f32x4 acc = {0.f, 0.f, 0.f, 0.f};
#pragma unroll
            for (int s2 = 0; s2 < 2; ++s2) acc = mma(ldsfrag(L + PL_KTS + swzB(16 * dt + fr, 4 * s2 + fq)), yt[s2], acc);
            acc = -acc;
            *(u32x2*)(negw + (size_t)us * 8192 + (16 * ct + fr) * 128 + 32 * (dt >> 1) + 8 * fq + 4 * (dt & 1)) = pack4(acc);
        }
        const int et = wid;
        bf16x8 yv[2];
#pragma unroll
        for (int s2 = 0; s2 < 2; ++s2) yv[s2] = ldsfrag(L + PL_VTS + swzB(16 * et + fr, 4 * s2 + fq));
#pragma unroll
        for (int c4 = 0; c4 < 4; ++c4) {
            f32x4 acc = {0.f, 0.f, 0.f, 0.f};
#pragma unroll
            for (int s2 = 0; s2 < 2; ++s2) acc = mma(ldsfrag(L + PL_TINV + swzB(16 * c4 + fr, 4 * s2 + fq)), yv[s2], acc);
            *(u32x2*)(uT + (size_t)us * 8192 + (16 * et + fr) * 64 + 16 * c4 + 4 * fq) = pack4(acc);
        }
    }
    __syncthreads();
}

constexpr int SC_BUF = 57344, SC_NEGW = 0, SC_QD = 16384, SC_KDT = 32768, SC_QK = 49152;
#define SCB() __builtin_amdgcn_sched_barrier(0)
__device__ __forceinline__ void scan_step(ldsp B, f32x4 (&S)[8], const u32x2 (&uc)[4], float dc, bf16_t* orow, int fr, int fq) {
    bf16x8 fa[8], fb[8];
    bf16x8 ys[4];
#pragma unroll
    for (int s = 0; s < 4; ++s) ys[s] = pack8(S[2 * s], S[2 * s + 1]);
    f32x4 vn[4], o[4];
#pragma unroll
    for (int ct = 0; ct < 4; ++ct) { vn[ct] = (f32x4){bflo(uc[ct].x), bfhi(uc[ct].x), bflo(uc[ct].y), bfhi(uc[ct].y)}; o[ct] = (f32x4){0.f, 0.f, 0.f, 0.f}; }
#define LD_P1(dst, s) do { _Pragma("unroll") for (int ct = 0; ct < 4; ++ct) { dst[ct] = ldsfrag(B + SC_NEGW + swzA(16 * ct + fr, 4 * (s) + fq)); dst[4 + ct] = ldsfrag(B + SC_QD + swzA(16 * ct + fr, 4 * (s) + fq)); } } while (0)
#define MM_P1(src, s) do { _Pragma("unroll") for (int ct = 0; ct < 4; ++ct) { vn[ct] = mma(src[ct], ys[s], vn[ct]); o[ct] = mma(src[4 + ct], ys[s], o[ct]); } } while (0)
#define LD_KD(dst, d0) do { _Pragma("unroll") for (int q = 0; q < 4; ++q) { dst[2 * q] = ldsfrag(B + SC_KDT + swzB(16 * ((d0) + q) + fr, fq)); dst[2 * q + 1] = ldsfrag(B + SC_KDT + swzB(16 * ((d0) + q) + fr, 4 + fq)); } } while (0)
#define MM_KD(src, d0) do { _Pragma("unroll") for (int q = 0; q < 4; ++q) { S[(d0) + q] = mma(src[2 * q], yv[0], S[(d0) + q]); } _Pragma("unroll") for (int q = 0; q < 4; ++q) { S[(d0) + q] = mma(src[2 * q + 1], yv[1], S[(d0) + q]); } } while (0)
    LD_P1(fa, 0); SCB();
    LD_P1(fb, 1); SCB(); MM_P1(fa, 0); SCB();
    LD_P1(fa, 2); SCB(); MM_P1(fb, 1); SCB();
    LD_P1(fb, 3); SCB(); MM_P1(fa, 2); SCB();
    LD_KD(fa, 0); SCB(); MM_P1(fb, 3); SCB();
#pragma unroll
    for (int dt = 0; dt < 8; ++dt) S[dt] = S[dt] * dc;
    LD_KD(fb, 4); SCB();
    bf16x8 yv[2];
#pragma unroll
    for (int s2 = 0; s2 < 2; ++s2) yv[s2] = pack8(vn[2 * s2], vn[2 * s2 + 1]);
    MM_KD(fa, 0); SCB();
#pragma unroll
    for (int ct = 0; ct < 4; ++ct) { fa[2 * ct] = ldsfrag(B + SC_QK + swzB(16 * ct + fr, fq)); fa[2 * ct + 1] = ldsfrag(B + SC_QK + swzB(16 * ct + fr, 4 + fq)); }
    SCB(); MM_KD(fb, 4); SCB();
#pragma unroll
    for (int ct = 0; ct < 4; ++ct) o[ct] = mma(fa[2 * ct], yv[0], o[ct]);
#pragma unroll
    for (int ct = 0; ct < 4; ++ct) o[ct] = mma(fa[2 * ct + 1], yv[1], o[ct]);
#pragma unroll
    for (int ct = 0; ct < 4; ++ct)
#pragma unroll
        for (int r = 0; r < 4; ++r) orow[(size_t)(16 * ct + 4 * fq + r) * LDHA] = (bf16_t)(pk2(o[ct][r], 0.f) & 0xffffu);
#undef LD_P1
#undef MM_P1
#undef LD_KD
#undef MM_KD
}
__device__ __forceinline__ void gdn_scan(ldsp L, int h, int eq, const bf16_t* negw, const bf16_t* qd, const bf16_t* kdT, const bf16_t* qk, const bf16_t* uT, const float* dch,
                                        bf16_t* hA, int tid, int wid, int lane) {
#define SC_BAR() asm volatile("s_waitcnt lgkmcnt(0)\n\ts_barrier" ::: "memory")
    const int fr = lane & 15, fq = lane >> 4, e0 = 32 * eq + 16 * wid;
    if (wid < 2) {
        f32x4 S[8];
#pragma unroll
        for (int d = 0; d < 8; ++d) S[d] = (f32x4){0.f, 0.f, 0.f, 0.f};
        u32x2 ua[4], ub[4]; float da, db;
#define SC_LOADU(un, dcn, nn) do { const size_t u_ = (size_t)h * 256 + (nn); \
        _Pragma("unroll") for (int ct = 0; ct < 4; ++ct) un[ct] = *(const u32x2*)(uT + u_ * 8192 + (size_t)(e0 + fr) * 64 + 16 * ct + 4 * fq); dcn = dch[u_]; } while (0)
        SC_LOADU(ua, da, 0); SC_LOADU(ub, db, 1);
        SC_BAR();
        for (int n = 0; n < 256; n += 2) {
            { u32x2 uc[4]; const float dc = da;
#pragma unroll
              for (int ct = 0; ct < 4; ++ct) uc[ct] = ua[ct];
              SC_LOADU(ua, da, (n + 2 < 256 ? n + 2 : 255));
              scan_step(L, S, uc, dc, hA + (size_t)(64 * n) * LDHA + h * 128 + e0 + fr, fr, fq);
              SC_BAR(); }
            { u32x2 uc[4]; const float dc = db;
#pragma unroll
              for (int ct = 0; ct < 4; ++ct) uc[ct] = ub[ct];
              SC_LOADU(ub, db, (n + 3 < 256 ? n + 3 : 255));
              scan_step(L + SC_BUF, S, uc, dc, hA + (size_t)(64 * (n + 1)) * LDHA + h * 128 + e0 + fr, fr, fq);
              SC_BAR(); }
        }
#undef SC_LOADU
    } else {
        const int w6 = wid - 2;
        u32x4 ra[10], rb[10];
#define SC_LOADS(r, nn) do { const size_t u_ = (size_t)h * 256 + (nn); \
        _Pragma("unroll") for (int i_ = 0; i_ < 10; ++i_) { const int idx_ = (w6 + 6 * i_) < 56 ? (w6 + 6 * i_) : 55; { const int a_ = idx_ >> 4, c_ = (idx_ & 15) * 64 + lane; \
            const bf16_t* b_ = a_ == 0 ? negw : a_ == 1 ? qd : a_ == 2 ? kdT : qk; \
            r[i_] = *(const u32x4*)(b_ + u_ * (a_ == 3 ? 4096 : 8192) + (size_t)c_ * 8); } } } while (0)
#define SC_STORES(r, buf) do { ldsp B_ = L + (buf) * SC_BUF; \
        _Pragma("unroll") for (int i_ = 0; i_ < 10; ++i_) { const int idx_ = (w6 + 6 * i_) < 56 ? (w6 + 6 * i_) : 55; { const int a_ = idx_ >> 4, c_ = (idx_ & 15) * 64 + lane; \
            const int off_ = a_ < 2 ? a_ * 16384 + swzA(c_ >> 4, c_ & 15) : (a_ == 2 ? SC_KDT : SC_QK) + swzB(c_ >> 3, c_ & 7); \
            *(LAS u32x4*)(B_ + off_) = r[i_]; } } } while (0)
        SC_LOADS(ra, 0); SC_STORES(ra, 0);
        SC_LOADS(rb, 1); SC_LOADS(ra, 2);
        SC_BAR();
        for (int n = 0; n < 256; n += 2) {
            SC_STORES(rb, 1);
            SC_LOADS(rb, (n + 3 < 256 ? n + 3 : 255));
            SC_BAR();
            SC_STORES(ra, 0);
            SC_LOADS(ra, (n + 4 < 256 ? n + 4 : 255));
            SC_BAR();
        }
#undef SC_LOADS
#undef SC_STORES
    }
}
#undef SC_BAR

__device__ __forceinline__ void gdn_out_rows(const bf16_t* hA, const float* gain, bf16_t* mix, int gw, int ngw, int lane) {
    const float2 gg = *(const float2*)(gain + 2 * lane);
    for (int m0 = gw; m0 < S_; m0 += 2 * ngw) {
        unsigned ov[2][6], gv[2][6];
#pragma unroll
        for (int q = 0; q < 2; ++q) {
            const int m = m0 + q * ngw < S_ ? m0 + q * ngw : m0;
            const bf16_t* rowp = hA + (size_t)m * LDHA;
#pragma unroll
            for (int h = 0; h < 6; ++h) { ov[q][h] = *(const unsigned*)(rowp + h * 128 + 2 * lane); gv[q][h] = *(const unsigned*)(rowp + 2304 + h * 128 + 2 * lane); }
        }
#pragma unroll
        for (int q = 0; q < 2; ++q) {
            const int m = m0 + q * ngw;
            if (m < S_) {
#pragma unroll
                for (int h = 0; h < 6; ++h) {
                    const float o0 = bflo(ov[q][h]), o1 = bfhi(ov[q][h]);
                    const float r = rsqrtf(wave_sum(o0 * o0 + o1 * o1) * (1.f / 128.f) + EPS);
                    *(unsigned*)(mix + (size_t)m * D_ + h * 128 + 2 * lane) = pk2(o0 * r * gg.x * silu_f(bflo(gv[q][h])), o1 * r * gg.y * silu_f(bfhi(gv[q][h])));
                }
            }
        }
    }
}

__device__ __forceinline__ int swzV(int r, int ch) { return r * 512 + ((ch ^ (r & 15)) << 4); }
__device__ __forceinline__ void mem_attn(ldsp L, const bf16_t* qsrc, int ldq, int qcol, const bf16_t* memK, const bf16_t* memVt, bf16_t* mix, int tid, int wid, int lane) {
    const int fr = lane & 15, fq = lane >> 4;
    const float SCL = 0.125f * 1.4426950408889634f;
    for (int unit = blockIdx.x; unit < 256; unit += gridDim.x) {
        const int hm = unit & 3, tb = unit >> 2;
#pragma unroll
        for (int i = 0; i < 4; ++i) { const int g = tid + 512 * i;
            *(LAS u32x4*)(L + swzB(g >> 3, g & 7)) = *(const u32x4*)(memK + (size_t)(g >> 3) * 256 + hm * 64 + (g & 7) * 8);
            *(LAS u32x4*)(L + 32768 + swzV(g >> 5, g & 31)) = *(const u32x4*)(memVt + (size_t)(hm * 64 + (g >> 5)) * 256 + (g & 31) * 8); }
        __syncthreads();
        for (int tl = wid; tl < 16; tl += NW) {
            const int tok0 = 256 * tb + 16 * tl;
            bf16x8 yq[2];
#pragma unroll
            for (int s = 0; s < 2; ++s) yq[s] = gfrag(qsrc + (size_t)(tok0 + fr) * ldq + qcol + hm * 64 + 32 * s + 8 * fq);
            f32x4 sc[16];
#pragma unroll
            for (int kb = 0; kb < 4; ++kb) {
                bf16x8 xk[8];
#pragma unroll
                for (int q = 0; q < 4; ++q) { xk[2 * q] = ldsfrag(L + swzB(16 * (4 * kb + q) + fr, fq)); xk[2 * q + 1] = ldsfrag(L + swzB(16 * (4 * kb + q) + fr, 4 + fq)); }
                SCB();
#pragma unroll
                for (int q = 0; q < 4; ++q) { sc[4 * kb + q] = mma(xk[2 * q], yq[0], (f32x4){0.f, 0.f, 0.f, 0.f}); sc[4 * kb + q] = mma(xk[2 * q + 1], yq[1], sc[4 * kb + q]); }
                SCB();
            }
            float mx = -1e30f;
#pragma unroll
            for (int kt = 0; kt < 16; ++kt)
#pragma unroll
                for (int r = 0; r < 4; ++r) mx = fmaxf(mx, sc[kt][r]);
            mx = fmaxf(mx, __shfl_xor(mx, 16)); mx = fmaxf(mx, __shfl_xor(mx, 32));
            float l = 0.f;
#pragma unroll
            for (int kt = 0; kt < 16; ++kt)
#pragma unroll
                for (int r = 0; r < 4; ++r) { const float pv = __builtin_amdgcn_exp2f((sc[kt][r] - mx) * SCL); sc[kt][r] = pv; l += pv; }
            l += __shfl_xor(l, 16); l += __shfl_xor(l, 32);
            const float rl = 1.f / l;
            f32x4 o[4];
#pragma unroll
            for (int dt = 0; dt < 4; ++dt) o[dt] = (f32x4){0.f, 0.f, 0.f, 0.f};
#pragma unroll
            for (int s = 0; s < 8; ++s) {
                const bf16x8 yp = pack8(sc[2 * s], sc[2 * s + 1]);
                bf16x8 xv[4];
#pragma unroll
                for (int dt = 0; dt < 4; ++dt) xv[dt] = ldsfrag(L + 32768 + swzV(16 * dt + fr, 4 * s + fq));
                SCB();
#pragma unroll
                for (int dt = 0; dt < 4; ++dt) o[dt] = mma(xv[dt], yp, o[dt]);
                SCB();
            }
#pragma unroll
            for (int dt = 0; dt < 4; ++dt) *(u32x2*)(mix + (size_t)(tok0 + fr) * D_ + 768 + hm * 64 + 16 * dt + 4 * fq) = pack4(o[dt] * rl);
        }
        __syncthreads();
    }
}

constexpr int AT_BUF = 40960, AT_KN = 0, AT_KR = 16384, AT_VT = 24576, AT_CTL = 2 * AT_BUF, AT_QR = 2 * AT_BUF + 1024;
__device__ __forceinline__ void mla_attn(ldsp L, const bf16_t* Qc, const bf16_t* Kc, const bf16_t* Vt, bf16_t* mix, unsigned* ctr, int tid, int wid, int lane) {
    const int fr = lane & 15, fq = lane >> 4;
    LAS int* ctl = (LAS int*)(L + AT_CTL);
    for (;;) {
        if (tid == 0) ctl[0] = (int)atomicAdd(ctr, 1u);
        __syncthreads();
        const int item = ctl[0];
        __syncthreads();
        if (item >= 384) break;
        const int qb = 63 - item / 6, h = item % 6;
        const int NT = 4 * qb + 4, q0 = 256 * qb + 32 * wid, tmax = 4 * qb + (wid >> 1);
        bf16x8 Q[2][4];
        const bf16_t* qrow = Qc + ((size_t)(q0 + fr) * 6 + h) * 192 + 8 * fq;
#pragma unroll
        for (int qs = 0; qs < 2; ++qs)
#pragma unroll
            for (int s = 0; s < 4; ++s) Q[qs][s] = gfrag(qrow + (size_t)qs * 16 * 1152 + 32 * s);
#pragma unroll
        for (int qs = 0; qs < 2; ++qs)
#pragma unroll
            for (int s = 0; s < 2; ++s) *(LAS bf16x8*)(L + AT_QR + wid * 4096 + (qs * 2 + s) * 1024 + lane * 16) = gfrag(qrow + (size_t)qs * 16 * 1152 + 128 + 32 * s);
        f32x4 O[2][8];
#pragma unroll
        for (int qs = 0; qs < 2; ++qs)
#pragma unroll
            for (int dt = 0; dt < 8; ++dt) O[qs][dt] = (f32x4){0.f, 0.f, 0.f, 0.f};
        float mrow[2] = {0.f, 0.f}, lrow[2] = {0.f, 0.f};
        const bf16_t* Kh = Kc + (size_t)h * S_ * 192; const bf16_t* Vh = Vt + (size_t)h * 128 * S_;
        const int rA = lane >> 4, cA = lane & 15, rB = lane >> 3, cB = lane & 7;
#define AT_DMA(t, buf) do { ldsp B_ = L + (buf) * AT_BUF; const size_t kb_ = (size_t)(t) * 64; \
        _Pragma("unroll") for (int i_ = 0; i_ < 2; ++i_) { const int pi_ = wid + 8 * i_, r_ = 4 * pi_ + rA; \
            __builtin_amdgcn_global_load_lds((const unsigned*)(Kh + (kb_ + r_) * 192 + ((cA ^ (r_ & 15)) << 3)), (LAS unsigned*)(B_ + AT_KN + pi_ * 1024), 16, 0, 0); } \
        { const int r_ = 8 * wid + rB; \
            __builtin_amdgcn_global_load_lds((const unsigned*)(Kh + (kb_ + r_) * 192 + 128 + ((cB ^ (r_ & 7)) << 3)), (LAS unsigned*)(B_ + AT_KR + wid * 1024), 16, 0, 0); } \
        _Pragma("unroll") for (int i_ = 0; i_ < 2; ++i_) { const int pi_ = wid + 8 * i_, r_ = 8 * pi_ + rB; \
            __builtin_amdgcn_global_load_lds((const unsigned*)(Vh + (size_t)r_ * S_ + kb_ + ((cB ^ (r_ & 7)) << 3)), (LAS unsigned*)(B_ + AT_VT + pi_ * 1024), 16, 0, 0); } } while (0)
        AT_DMA(0, 0);
        asm volatile("s_waitcnt vmcnt(0)" ::: "memory");
        __syncthreads();
        for (int t = 0; t < NT; ++t) {
            if (t + 1 < NT) AT_DMA(t + 1, (t + 1) & 1);
            if (t <= tmax) {
                ldsp B = L + (t & 1) * AT_BUF;
                f32x4 sc[2][4];
                bf16x8 Qr[2][2];
#pragma unroll
                for (int qs = 0; qs < 2; ++qs)
#pragma unroll
                    for (int s = 0; s < 2; ++s) Qr[qs][s] = ldsfrag(L + AT_QR + wid * 4096 + (qs * 2 + s) * 1024 + lane * 16);
                bf16x8 xa[6], v0[8];
#define AT_LDK(dst, kt) do { _Pragma("unroll") for (int s = 0; s < 4; ++s) dst[s] = ldsfrag(B + AT_KN + swzA(16 * (kt) + fr, 4 * s + fq)); \
                             dst[4] = ldsfrag(B + AT_KR + swzB(16 * (kt) + fr, fq)); dst[5] = ldsfrag(B + AT_KR + swzB(16 * (kt) + fr, 4 + fq)); } while (0)
#define AT_MMK(src, kt) do { sc[0][kt] = (f32x4){-mrow[0], -mrow[0], -mrow[0], -mrow[0]}; sc[1][kt] = (f32x4){-mrow[1], -mrow[1], -mrow[1], -mrow[1]}; \
                             _Pragma("unroll") for (int s = 0; s < 4; ++s) { sc[0][kt] = mma(src[s], Q[0][s], sc[0][kt]); sc[1][kt] = mma(src[s], Q[1][s], sc[1][kt]); } \
                             _Pragma("unroll") for (int s = 0; s < 2; ++s) { sc[0][kt] = mma(src[4 + s], Qr[0][s], sc[0][kt]); sc[1][kt] = mma(src[4 + s], Qr[1][s], sc[1][kt]); } } while (0)
#define AT_LDV(dst, d0) do { _Pragma("unroll") for (int q = 0; q < 4; ++q) { dst[2 * q] = ldsfrag(B + AT_VT + swzB(16 * ((d0) + q) + fr, fq)); dst[2 * q + 1] = ldsfrag(B + AT_VT + swzB(16 * ((d0) + q) + fr, 4 + fq)); } } while (0)
#define AT_MMV(src, d0) do { _Pragma("unroll") for (int q = 0; q < 4; ++q) { \
                             O[0][(d0) + q] = mma(src[2 * q], yp[0][0], O[0][(d0) + q]); O[1][(d0) + q] = mma(src[2 * q], yp[1][0], O[1][(d0) + q]); } \
                             _Pragma("unroll") for (int q = 0; q < 4; ++q) { \
                             O[0][(d0) + q] = mma(src[2 * q + 1], yp[0][1], O[0][(d0) + q]); O[1][(d0) + q] = mma(src[2 * q + 1], yp[1][1], O[1][(d0) + q]); } } while (0)
                AT_LDK(xa, 0); SCB(); AT_MMK(xa, 0); SCB();
                AT_LDK(xa, 1); SCB(); AT_MMK(xa, 1); SCB();
                AT_LDK(xa, 2); SCB(); AT_MMK(xa, 2); SCB();
                AT_LDK(xa, 3); SCB(); AT_MMK(xa, 3); SCB(); AT_LDV(v0, 0); SCB();
                bf16x8 yp[2][2];
#pragma unroll
                for (int qs = 0; qs < 2; ++qs) {
                    float mx = -1e30f;
#pragma unroll
                    for (int kt = 0; kt < 4; ++kt)
#pragma unroll
                        for (int r = 0; r < 4; ++r) mx = fmaxf(mx, sc[qs][kt][r]);
                    mx = fmaxf(mx, __shfl_xor(mx, 16)); mx = fmaxf(mx, __shfl_xor(mx, 32));
                    if (__any(t == 0 || mx > 8.f)) {
                        const float dl = t == 0 ? mx : fmaxf(mx, 0.f), alpha = __builtin_amdgcn_exp2f(-dl);
                        mrow[qs] += dl; lrow[qs] *= alpha;
#pragma unroll
                        for (int kt = 0; kt < 4; ++kt) sc[qs][kt] = sc[qs][kt] - dl;
#pragma unroll
                        for (int dt = 0; dt < 8; ++dt) O[qs][dt] = O[qs][dt] * alpha;
                    }
                    float ls = 0.f;
#pragma unroll
                    for (int kt = 0; kt < 4; ++kt)
#pragma unroll
                        for (int r = 0; r < 4; ++r) { const float pv = __builtin_amdgcn_exp2f(sc[qs][kt][r]); sc[qs][kt][r] = pv; ls += pv; }
                    lrow[qs] += ls;
                    yp[qs][0] = pack8(sc[qs][0], sc[qs][1]); yp[qs][1] = pack8(sc[qs][2], sc[qs][3]);
                }
                SCB(); AT_MMV(v0, 0); SCB(); AT_LDV(v0, 4); SCB(); AT_MMV(v0, 4); SCB();
#undef AT_LDK
#undef AT_MMK
#undef AT_LDV
#undef AT_MMV
            }
            asm volatile("s_waitcnt vmcnt(0)" ::: "memory");
            __syncthreads();
        }
#undef AT_DMA
#pragma unroll
        for (int qs = 0; qs < 2; ++qs) {
            float l = lrow[qs]; l += __shfl_xor(l, 16); l += __shfl_xor(l, 32);
            const float rl = 1.f / l;
#pragma unroll
            for (int dt = 0; dt < 8; ++dt) *(u32x2*)(mix + (size_t)(q0 + 16 * qs + fr) * D_ + h * 128 + 16 * dt + 4 * fq) = pack4(O[qs][dt] * rl);
        }
    }
}


#define XB_TMO      128
#define XB_XCNT(j)  (256  + 64 * (j))
#define XB_XSUB(j)  (1280 + 64 * (j))
#define XB_XGEN(j)  (2304 + 64 * (j))
#define XB_TOP      3328
#define XB_TOPGEN   3392
#define XCD_BAR_WORDS 3456
#define XB_SPIN_CAP (1u << 18)

__device__ __forceinline__ unsigned xb_ld(unsigned* p)              { return __hip_atomic_load(p, __ATOMIC_RELAXED, __HIP_MEMORY_SCOPE_AGENT); }
__device__ __forceinline__ unsigned xb_add(unsigned* p, unsigned v) { return __hip_atomic_fetch_add(p, v, __ATOMIC_RELAXED, __HIP_MEMORY_SCOPE_AGENT); }
__device__ __forceinline__ unsigned xb_xcc_id() { return (unsigned)__builtin_amdgcn_s_getreg((3 << 11) | 20) & 0xFu; }
#define XB_SPIN(cond, bar) do { unsigned _sp = 0; while (cond) { __builtin_amdgcn_s_sleep(1); \
    if ((++_sp & 255u) == 0u) { if (xb_ld(&(bar)[XB_TMO])) break; if (_sp > XB_SPIN_CAP) { atomicAdd(&(bar)[XB_TMO], 1u); break; } } } } while (0)

struct XcdBarrier {
    unsigned* bar; unsigned x;
    volatile LAS unsigned* st;
};

__device__ __forceinline__ XcdBarrier xcd_barrier_post(unsigned* bar, volatile LAS unsigned* st) {
    XcdBarrier b; b.bar = bar; b.x = xb_xcc_id(); b.st = st;
    if (threadIdx.x == 0) (void)xb_add(&bar[XB_XCNT(b.x)], 1u);
    return b;
}
__device__ __forceinline__ void xcd_barrier_complete(unsigned* bar, unsigned x, unsigned& nloc, unsigned& nx) {
    const unsigned G = gridDim.x * gridDim.y * gridDim.z;
    unsigned sum, cnt, mine, sp = 0u;
    for (;;) {
        sum = 0u; cnt = 0u; mine = 0u;
#pragma unroll
        for (unsigned j = 0; j < 16; ++j) { const unsigned c = xb_ld(&bar[XB_XCNT(j)]); sum += c; cnt += (c > 0u) ? 1u : 0u; mine = (j == x) ? c : mine; }
        if (sum == G) break;
        __builtin_amdgcn_s_sleep(1);
        if ((++sp & 255u) == 0u) { if (xb_ld(&bar[XB_TMO])) break; if (sp > XB_SPIN_CAP) { atomicAdd(&bar[XB_TMO], 1u); break; } }
    }
    nloc = mine > 0u ? mine : 1u; nx = cnt > 0u ? cnt : 1u;
}

__device__ __forceinline__ void xcd_barrier(const XcdBarrier& b) {
    asm volatile("s_waitcnt vmcnt(0)" ::: "memory");
    __syncthreads();
    if (threadIdx.x == 0) {
        unsigned* bar = b.bar;
        __builtin_amdgcn_s_waitcnt(0);
        unsigned nloc = b.st[0], nx = b.st[1];
        if (nloc == 0u) { xcd_barrier_complete(bar, b.x, nloc, nx); b.st[0] = nloc; b.st[1] = nx; }
        const unsigned old = xb_add(&bar[XB_XSUB(b.x)], 1u);
        const unsigned gen = old / nloc;
        if (old + 1u == (gen + 1u) * nloc) {
            __builtin_amdgcn_fence(__ATOMIC_RELEASE, "agent");
            asm volatile("s_waitcnt vmcnt(0)" ::: "memory");
            const unsigned og = xb_add(&bar[XB_TOP], 1u);
            const unsigned tg = og / nx;
            if (og + 1u == (tg + 1u) * nx) xb_add(&bar[XB_TOPGEN], 1u);
            else XB_SPIN(xb_ld(&bar[XB_TOPGEN]) == tg, bar);
            __builtin_amdgcn_fence(__ATOMIC_ACQUIRE, "agent");
            xb_add(&bar[XB_XGEN(b.x)], 1u);
            asm volatile("s_waitcnt vmcnt(0)" ::: "memory");
        } else {
            XB_SPIN(xb_ld(&bar[XB_XGEN(b.x)]) == gen, bar);
            __builtin_amdgcn_fence(__ATOMIC_ACQUIRE, "agent");
            asm volatile("s_waitcnt vmcnt(0)" ::: "memory");
        }
    }
    __syncthreads();
}

#ifndef RP_GU
#define RP_GU 1
#endif
#ifndef RP_INA
#define RP_INA 1
#endif
#ifndef RP_PREP
#define RP_PREP 1
#endif
#ifndef RP_SCAN
#define RP_SCAN 1
#endif
#ifndef RP_ATTN
#define RP_ATTN 1
#endif
#ifndef RP_MEM
#define RP_MEM 1
#endif
#ifndef RP_CONV
#define RP_CONV 1
#endif
#ifndef RP_UQ
#define RP_UQ 1
#endif
#ifndef RP_OUTROWS
#define RP_OUTROWS 1
#endif
#ifndef RP_P0
#define RP_P0 1
#endif
#ifndef REP_MEM
#define REP_MEM 1
#endif
#ifndef REP_ROWS
#define REP_ROWS 1
#endif
#ifndef REP_RES
#define REP_RES 1
#endif
#ifndef REP_INPROJ
#define REP_INPROJ 1
#endif
#ifndef REP_CONV
#define REP_CONV 1
#endif
#ifndef REP_GU
#define REP_GU 1
#endif
#ifndef REP_ATTN
#define REP_ATTN 1
#endif
#ifndef REP_SCAN
#define REP_SCAN 1
#endif
#ifndef REP_SYNC
#define REP_SYNC 1
#endif
#ifndef REP_PREP
#define REP_PREP 1
#endif
#define PHASE_IDS int tid_o_ = threadIdx.x; asm volatile("" : "+v"(tid_o_)); const int tid = tid_o_, lane = tid & 63, wid = __builtin_amdgcn_readfirstlane(tid >> 6), gw = bx * NW + wid; (void)lane; (void)gw; (void)tid
#define GSYNC_CG() do { asm volatile("s_waitcnt vmcnt(0) lgkmcnt(0)" ::: "memory"); grid.sync(); } while (0)
#define GSYNC() do { for (int r_ = 0; r_ < REP_SYNC; ++r_) xcd_barrier(xbar); } while (0)
#define CONV_UPPER(l_, grp_) do { if (2 * bx >= G) conv_group((const float* const*)(ws_ + WS_TAB), ws_, (l_), (grp_), L, (bx - G / 2) * NW + wid, (G - G / 2) * NW, lane, wid); __syncthreads();   } while (0)
#define SSQ(k) (WSP(float, WS_SSQ) + (size_t)(k) * S_ * 16)
#define WSP(T, off) ((T*)(ws_ + (off)))
#define INP(k) gptr(((const float* const*)(ws_ + WS_TAB)) + (k))
#define PHASE_BEGIN GAS unsigned char* wsg_ = (GAS unsigned char*)p.ws; int bx = blockIdx.x; asm volatile("" : "+s"(wsg_), "+s"(bx)); unsigned char* ws_ = (unsigned char*)wsg_; PHASE_IDS
__global__ void __launch_bounds__(NTHREADS, 2) fwd_megakernel(Params p) {
    extern __shared__ __attribute__((aligned(16))) unsigned char lds_raw[];
    cg::grid_group grid = cg::this_grid();
    ldsp L = (ldsp)lds_raw;
    const int G = gridDim.x, ngw = G * NW;
    volatile LAS unsigned* xst = (volatile LAS unsigned*)(L + XB_LDS_OFF);
    if (threadIdx.x < 2) xst[threadIdx.x] = 0u;
    __syncthreads();
    const XcdBarrier xbar = xcd_barrier_post((unsigned*)(p.ws + WS_XBAR), xst);

    {
        PHASE_BEGIN;
        if (tid == 0) {
            const float** T = (const float**)(ws_ + WS_TAB);
#pragma unroll
            for (int k = 0; k < 26; ++k) T[k] = p.in[k];
            float* TF = (float*)(ws_ + WS_TAB + 512);
#pragma unroll
            for (int k = 0; k < 32; ++k) TF[k] = p.invf[k];
        }
        asm volatile("s_waitcnt vmcnt(0)" ::: "memory");
        __syncthreads();
        __builtin_amdgcn_fence(__ATOMIC_ACQUIRE, "agent");
        const float* const* tin = (const float* const*)(ws_ + WS_TAB);
        LAS float* scr = (LAS float*)(L + wid * 16384);
        conv_group(tin, ws_, 0, 0, L, gw, ngw, lane, wid);
        conv_job(INP(22), D_, 320, 512, 0, WSP(bf16_t, WS_DKVT), scr, gw, ngw, lane, INP(21));
        conv_job(INP(24), 256, 1536, 768, 4, WSP(bf16_t, WS_UKT), scr, gw, ngw, lane);
        conv_job(INP(24), 256, 1536, 768, 5, WSP(bf16_t, WS_UVT), scr, gw, ngw, lane);
        norm_rows(INP(1), INP(11), WSP(bf16_t, WS_MEMN), 256, gw, ngw, lane);
        {
            const float* xin = INP(0); bf16_t* XB = WSP(bf16_t, WS_XN); float* sq0 = SSQ(12);
            for (int m = gw; m < S_; m += ngw) {
                float s = 0.f;
#pragma unroll
                for (int j = 0; j < 4; ++j) { const f32x4 v = *(const f32x4*)(xin + (size_t)m * D_ + 4 * lane + 256 * j);
                    u32x2 w; w.x = pk2(v[0], v[1]); w.y = pk2(v[2], v[3]); *(u32x2*)(XB + (size_t)m * D_ + 4 * lane + 256 * j) = w;
                    const float y0 = bflo(w.x), y1 = bfhi(w.x), y2 = bflo(w.y), y3 = bfhi(w.y); s += (y0 * y0 + y1 * y1) + (y2 * y2 + y3 * y3); }
                s = wave_sum(s);
                if (lane < 16) sq0[(size_t)m * 16 + lane] = lane == 0 ? s : 0.f;
            }
        }
        const int* positions = (const int*)INP(2);
        float2* ROPE = WSP(float2, WS_ROPE);
        for (int i = bx * NTHREADS + tid; i < S_ * 32; i += G * NTHREADS) {
            const int row = i >> 5, j = i & 31;
            const double a = (double)positions[row] * (double)((const float*)(ws_ + WS_TAB + 512))[j];
            const double rev = a * 0.15915494309189535; const float f = (float)(rev - rint(rev));
            ROPE[i] = make_float2(__builtin_amdgcn_cosf(f), __builtin_amdgcn_sinf(f));
        }
    }
    GSYNC_CG();

    for (int l = 0; l < 4; ++l) {
        const bool isA = l < 2;
        for (int rp_ = 0; rp_ < RP_GU; ++rp_) { PHASE_BEGIN; EpiSwiglu E{WSP(bf16_t, WS_H), l == 0 ? SSQ(12) : SSQ(3 * (l - 1) + 2)}; run_gemm(L, WSP(bf16_t, WS_XN), WSP(bf16_t, WS_W) + WO_GU1, S_, NGU, D_, bx, E); CONV_UPPER(l, 1); }
        {
            PHASE_BEGIN;
            EpiStore<true> Ek{WSP(bf16_t, WS_MEMK), 256, nullptr}; run_gemm(L, WSP(bf16_t, WS_MEMN), WSP(bf16_t, WS_W) + WO_MKV, 256, 256, D_, (bx + 1) % G, Ek);
            EpiStore<false> Ev{WSP(bf16_t, WS_MEMVT), 256, nullptr}; run_gemm(L, WSP(bf16_t, WS_W) + WO_MKV + (size_t)256 * D_, WSP(bf16_t, WS_MEMN), 256, 256, D_, (bx + 2) % G, Ev);
        }
        GSYNC();
        { PHASE_BEGIN; EpiResid E{WSP(bf16_t, WS_XN), 0.5f, SSQ(3 * l)}; run_gemm<EpiResid, false>(L, WSP(bf16_t, WS_H), WSP(bf16_t, WS_W) + WO_D1, S_, D_, DFF, bx, E); }
        GSYNC();
        if (isA) {
            for (int rp_ = 0; rp_ < RP_INA; ++rp_) { PHASE_BEGIN; EpiStore<true> E{WSP(bf16_t, WS_HA), LDHA, SSQ(3 * l)}; run_gemm(L, WSP(bf16_t, WS_XN), WSP(bf16_t, WS_W) + WO_IN, S_, LDHA, D_, bx, E); CONV_UPPER(l, 2); }
            GSYNC();
            {
                PHASE_BEGIN;
                const float* convw = INP(14) + (size_t)l * 4 * 2304;
                for (int rp_ = 0; rp_ < RP_PREP; ++rp_) for (int u = bx; u < 1536; u += G) {
                    const int h = u % 6;
                    gdn_prep_unit(L, u, WSP(bf16_t, WS_HA), convw, __expf(INP(15)[l * 6 + h]), INP(16)[l * 6 + h],
                                  WSP(bf16_t, WS_NEGW), WSP(bf16_t, WS_QD), WSP(bf16_t, WS_KDT), WSP(bf16_t, WS_QK), WSP(bf16_t, WS_UT), WSP(float, WS_DCH), tid, wid, lane);
                }
            }
            for (int rp_ = 0; rp_ < RP_MEM; ++rp_) { PHASE_BEGIN; mem_attn(L, WSP(bf16_t, WS_HA), LDHA, QMA, WSP(bf16_t, WS_MEMK), WSP(bf16_t, WS_MEMVT), WSP(bf16_t, WS_MIX), tid, wid, lane); }
            GSYNC();
            for (int rp_ = 0; rp_ < RP_SCAN; ++rp_) if (blockIdx.x < 24) { PHASE_BEGIN; gdn_scan(L, bx >> 2, bx & 3, WSP(bf16_t, WS_NEGW), WSP(bf16_t, WS_QD), WSP(bf16_t, WS_KDT), WSP(bf16_t, WS_QK),
                                  WSP(bf16_t, WS_UT), WSP(float, WS_DCH), WSP(bf16_t, WS_HA), tid, wid, lane); }
            GSYNC();
            for (int rp_ = 0; rp_ < RP_OUTROWS; ++rp_) { PHASE_BEGIN; gdn_out_rows(WSP(bf16_t, WS_HA), INP(17) + l * 128, WSP(bf16_t, WS_MIX), gw, ngw, lane); }
            GSYNC();
        } else {
            { PHASE_BEGIN; EpiInB E{WSP(bf16_t, WS_HB), WSP(bf16_t, WS_CQN), SSQ(3 * l), WSP(float, WS_SQQ)}; run_gemm(L, WSP(bf16_t, WS_XN), WSP(bf16_t, WS_W) + WO_IN, S_, LDHB, D_, bx, E); CONV_UPPER(l, 2); }
            GSYNC();
            for (int rp_ = 0; rp_ < RP_UQ; ++rp_) { PHASE_BEGIN; EpiQ E{WSP(bf16_t, WS_QCAT), WSP(float2, WS_ROPE), 0.07216878364870323f * 1.4426950408889634f, WSP(float, WS_SQQ)}; run_gemm(L, WSP(bf16_t, WS_CQN), WSP(bf16_t, WS_W) + WO_UQ, S_, 1280, 256, bx, E); }
            GSYNC();
            for (int rp_ = 0; rp_ < RP_MEM; ++rp_) { PHASE_BEGIN; mem_attn(L, WSP(bf16_t, WS_HB), LDHB, QMB, WSP(bf16_t, WS_MEMK), WSP(bf16_t, WS_MEMVT), WSP(bf16_t, WS_MIX), tid, wid, lane); }
            for (int rp_ = 0; rp_ < RP_ATTN; ++rp_) { PHASE_BEGIN; mla_attn(L, WSP(bf16_t, WS_QCAT), WSP(bf16_t, WS_KCAT), WSP(bf16_t, WS_VT), WSP(bf16_t, WS_MIX), WSP(unsigned, WS_CTL) + 64 * (l - 2) + 128 * rp_, tid, wid, lane); __syncthreads(); }
            GSYNC();
        }
        { PHASE_BEGIN; EpiResid E{WSP(bf16_t, WS_XN), 1.0f, SSQ(3 * l + 1)}; run_gemm<EpiResid, false>(L, WSP(bf16_t, WS_MIX), WSP(bf16_t, WS_W) + WO_OUT, S_, D_, D_, bx, E); }
        GSYNC();
        for (int rp_ = 0; rp_ < RP_GU; ++rp_) { PHASE_BEGIN; EpiSwiglu E{WSP(bf16_t, WS_H), SSQ(3 * l + 1)}; run_gemm(L, WSP(bf16_t, WS_XN), WSP(bf16_t, WS_W) + WO_GU2, S_, NGU, D_, bx, E); if (l < 3) CONV_UPPER(l + 1, 0); }
        GSYNC();
        { PHASE_BEGIN; EpiResid E{WSP(bf16_t, WS_XN), 0.5f, SSQ(3 * l + 2)}; run_gemm<EpiResid, false>(L, WSP(bf16_t, WS_H), WSP(bf16_t, WS_W) + WO_D2, S_, D_, DFF, bx, E); }
        GSYNC();
        if (l == 1) {
            { PHASE_BEGIN; EpiStore<true> E{WSP(bf16_t, WS_HB), 512, SSQ(5)}; run_gemm(L, WSP(bf16_t, WS_XN), WSP(bf16_t, WS_DKVT), S_, 512, D_, bx, E); }
            GSYNC();
            {
                PHASE_BEGIN;
                const bf16_t* CKR = WSP(bf16_t, WS_HB); bf16_t* CKVN = WSP(bf16_t, WS_CQN); bf16_t* KCAT = WSP(bf16_t, WS_KCAT); const float2* ROPE = WSP(float2, WS_ROPE);
                const f32x4 gg = *(const f32x4*)(INP(23) + 4 * lane);
                for (int m = gw; m < S_; m += ngw) {
                    const bf16_t* rp = CKR + (size_t)m * 512;
                    const u32x2 v = *(const u32x2*)(rp + 4 * lane);
                    const float a0 = bflo(v.x), a1 = bfhi(v.x), a2 = bflo(v.y), a3 = bfhi(v.y);
                    const float r = rsqrtf(wave_sum(a0 * a0 + a1 * a1 + a2 * a2 + a3 * a3) * (1.f / 256.f) + EPS);
                    u32x2 w; w.x = pk2(a0 * r * gg[0], a1 * r * gg[1]); w.y = pk2(a2 * r * gg[2], a3 * r * gg[3]);
                    *(u32x2*)(CKVN + (size_t)m * 256 + 4 * lane) = w;
                    if (lane < 32) {
                        const float x1 = bf2f(rp[256 + lane]), x2 = bf2f(rp[288 + lane]);
                        const float2 cs = ROPE[(size_t)m * 32 + lane];
                        const unsigned o = pk2(x1 * cs.x - x2 * cs.y, x1 * cs.y + x2 * cs.x);
#pragma unroll
                        for (int h = 0; h < 6; ++h) { bf16_t* kp = KCAT + ((size_t)h * S_ + m) * 192 + 128 + lane; kp[0] = (bf16_t)(o & 0xffffu); kp[32] = (bf16_t)(o >> 16); }
                    }
                }
            }
            GSYNC();
            { PHASE_BEGIN; EpiKnope E{WSP(bf16_t, WS_KCAT)}; run_gemm(L, WSP(bf16_t, WS_CQN), WSP(bf16_t, WS_UKT), S_, 768, 256, bx, E); }
            { PHASE_BEGIN; EpiStore<false> E{WSP(bf16_t, WS_VT), S_, nullptr}; run_gemm(L, WSP(bf16_t, WS_UVT), WSP(bf16_t, WS_CQN), 768, S_, 256, bx, E); }
            GSYNC();
        }
    }
    {
        PHASE_BEGIN;
        const float* g = INP(25); const bf16_t* XB = WSP(bf16_t, WS_XN);
        for (int m = gw; m < S_; m += ngw) {
            float* orow = p.out + (size_t)m * D_;
            f32x4 v[4]; float s = 0.f;
#pragma unroll
            for (int j = 0; j < 4; ++j) { const u32x2 w = *(const u32x2*)(XB + (size_t)m * D_ + 4 * lane + 256 * j);
                v[j] = (f32x4){bflo(w.x), bfhi(w.x), bflo(w.y), bfhi(w.y)}; s += (v[j][0] * v[j][0] + v[j][1] * v[j][1]) + (v[j][2] * v[j][2] + v[j][3] * v[j][3]); }
            const float r = rsqrtf(wave_sum(s) * (1.f / D_) + EPS);
#pragma unroll
            for (int j = 0; j < 4; ++j) { const f32x4 gg = *(const f32x4*)(g + 4 * lane + 256 * j); *(f32x4*)(orow + 4 * lane + 256 * j) = v[j] * r * gg; }
        }
    }
}

extern "C" void kernel_launch(void* const* d_in, const int* in_sizes, int n_in, void* d_out, int out_size, void* d_ws, size_t ws_size, hipStream_t stream) {
    static int grid_blocks = 0;
    if (grid_blocks == 0) {
        int dev = 0, cus = 0, per_cu = 0;
        hipGetDevice(&dev);
        hipDeviceGetAttribute(&cus, hipDeviceAttributeMultiprocessorCount, dev);
        hipFuncSetAttribute((const void*)fwd_megakernel, hipFuncAttributeMaxDynamicSharedMemorySize, LDS_BYTES);
        hipOccupancyMaxActiveBlocksPerMultiprocessor(&per_cu, (const void*)fwd_megakernel, NTHREADS, LDS_BYTES);
        if (per_cu < 1) per_cu = 1;
        grid_blocks = cus * per_cu;
        if (ws_size < WS_END) fprintf(stderr, "kernel_launch: workspace too small: %zu < %zu\n", ws_size, (size_t)WS_END);
    }
    (void)hipMemsetAsync((char*)d_ws + WS_CTL, 0, CTL_ZERO_BYTES, stream);
    Params p{};
    for (int i = 0; i < 26; ++i) p.in[i] = (const float*)d_in[i];
    p.out = (float*)d_out; p.ws = (unsigned char*)d_ws;
    for (int j = 0; j < 32; ++j) p.invf[j] = (float)pow(10000.0, -(double)(2 * j) / 64.0);
    void* args[] = {&p};
    hipError_t e = hipLaunchCooperativeKernel((const void*)fwd_megakernel, dim3(grid_blocks), dim3(NTHREADS), args, LDS_BYTES, stream);
    if (e != hipSuccess) fprintf(stderr, "cooperative launch failed: %s (grid %d)\n", hipGetErrorString(e), grid_blocks);
}
```

```cpp
#include <hip/hip_runtime.h>
#include <hip/hip_cooperative_groups.h>
#include <cstdio>
#include <cstdint>
#include <cmath>
namespace cg = cooperative_groups;
namespace pg8 {
#define PG8_LAS __attribute__((address_space(3)))
typedef unsigned short bf16_t;
typedef short bf16x8 __attribute__((ext_vector_type(8)));
typedef float f32x4 __attribute__((ext_vector_type(4)));
typedef unsigned u32x4 __attribute__((ext_vector_type(4)));
constexpr int BM = 256, BK = 64, HALF = 128, HTB = HALF * BK * 2  , STAGE_BYTES = 8 * HTB, NXCD = 8, WGM = 8;

__host__ __device__ __forceinline__ int lds_byte(int r, int c) { const int st = (r >> 4) * 2 + (c >> 5), rr = r & 15, cc = c & 31, ob = rr * 64 + cc * 2; return st * 1024 + (ob ^ (((ob >> 9) & 1) << 5)); }
__host__ __device__ __forceinline__ void stage_rc(int b, int& R, int& C) { const int st = b / 1024, sb = b % 1024, swz = sb ^ (((sb >> 9) & 1) << 5); R = (st >> 1) * 16 + swz / 64; C = (st & 1) * 32 + (swz % 64) / 2; }
__host__ __device__ __forceinline__ int perm32(int rho) { const int n = rho >> 4, i = rho & 15; return 8 * (i >> 2) + 4 * n + (i & 3); }

struct Unit { int pm, pn; };
struct Gemm { const bf16_t* A; const bf16_t* Bt; int M, N, K; };

struct StaticOrder {
    int nM, nN, nwg, G, c;
    __host__ __device__ void init(int M, int N, int G_, int c_) { nM = M / BM; nN = N / BM; nwg = nM * nN; G = G_; c = c_; }
    __host__ __device__ bool next(int i, Unit& u) const {
        const long L = (long)i * G + c; if (L >= nwg) return false;
        int wgid = (int)L; { const int q = nwg / NXCD, r = nwg % NXCD, xcd = wgid % NXCD, off = wgid / NXCD; wgid = (xcd < r ? xcd * (q + 1) : r * (q + 1) + (xcd - r) * q) + off; }
        const int nig = WGM * nN, gid = wgid / nig, fm = gid * WGM, gsz = (nM - fm) < WGM ? (nM - fm) : WGM;
        u.pm = fm + ((wgid % nig) % gsz); u.pn = (wgid % nig) / gsz; return true;
    }
    __device__ __forceinline__ void a_ready(const Unit&) const {}
    __device__ __forceinline__ void done(const Unit&) const {}
};

__device__ __forceinline__ unsigned cvt_pk_bf16(float lo, float hi) { unsigned r; asm volatile("v_cvt_pk_bf16_f32 %0, %1, %2" : "=v"(r) : "v"(lo), "v"(hi)); return r; }
typedef float f32x2 __attribute__((ext_vector_type(2)));
template <class Epi, class Sched, bool ALIGN_EPI = false, bool SP2 = false>
__device__ __forceinline__ void gemm_phase(PG8_LAS unsigned char* lds, const Gemm g, const Sched& S, const Epi& E) {
    int tid_o = threadIdx.x; asm volatile("" : "+v"(tid_o)); const int tid = tid_o, wid = __builtin_amdgcn_readfirstlane(tid >> 6), lane = tid & 63, wr = wid >> 2, wc = wid & 3, fr = lane & 15, fq = lane >> 4;
    const int K = g.K, nt = K / BK;
    unsigned voffA[2], voffB[2];
#pragma unroll
    for (int i = 0; i < 2; ++i) { int R, C; stage_rc(tid * 16 + i * 8192, R, C); const int Rb = Epi::PERM ? ((R & ~31) + perm32(R & 31)) : R;
        voffA[i] = (unsigned)(R * K + C) * 2u; voffB[i] = (unsigned)(Rb * K + C) * 2u; }
    const size_t kstep = (size_t)(BK * 2);
    const size_t hstep = (size_t)HALF * K * 2;
    const size_t tstep = 2 * hstep;
    const unsigned ldsw = (unsigned)wid * 1024u;
    const int aoff = lds_byte(wr * 64 + fr, fq * 8), boff = lds_byte(wc * 32 + fr, fq * 8);
#define PG8_SA(b, h) (((b) * 2 + (h)) * HTB)
#define PG8_SB(b, h) ((4 + (b) * 2 + (h)) * HTB)
#define PG8_STAGE(bufoff, gbase, voff) do { _Pragma("unroll") for (int _i = 0; _i < 2; ++_i) \
        __builtin_amdgcn_global_load_lds((const unsigned*)((const char*)(gbase) + (voff)[_i]), (PG8_LAS unsigned*)(lds + (bufoff) + ldsw + _i * 8192), 16, 0, 0); } while (0)
#define PG8_LDA(dst, b, h) do { _Pragma("unroll") for (int m = 0; m < 4; ++m) _Pragma("unroll") for (int k = 0; k < 2; ++k) dst[m][k] = *(const PG8_LAS bf16x8*)(lds + PG8_SA(b, h) + aoff + m * 2048 + k * 1024); } while (0)
#define PG8_LDB(dst, b, h) do { _Pragma("unroll") for (int n = 0; n < 2; ++n) _Pragma("unroll") for (int k = 0; k < 2; ++k) dst[n][k] = *(const PG8_LAS bf16x8*)(lds + PG8_SB(b, h) + boff + n * 2048 + k * 1024); } while (0)
#define PG8_MMA(ai, bj, At, Bt) do { __builtin_amdgcn_s_setprio(1); _Pragma("unroll") for (int m = 0; m < 4; ++m) _Pragma("unroll") for (int n = 0; n < 2; ++n) _Pragma("unroll") for (int k = 0; k < 2; ++k) \
        acc[ai][bj][m][n] = __builtin_amdgcn_mfma_f32_16x16x32_bf16(Bt[n][k], At[m][k], acc[ai][bj][m][n], 0, 0, 0); __builtin_amdgcn_s_setprio(0); } while (0)
#define PG8_WAIT_V(n) asm volatile("s_waitcnt vmcnt(" #n ")" ::: "memory")
#define PG8_WAIT_L(n) asm volatile("s_waitcnt lgkmcnt(" #n ")" ::: "memory")
#define PG8_BAR __builtin_amdgcn_s_barrier()
#define PG8_SCHED __builtin_amdgcn_sched_barrier(0)
    Unit cur, nxt; int ui = 0;
    if (!S.next(0, cur)) return;
    f32x4 acc[2][2][4][2];
#pragma unroll
    for (int a = 0; a < 2; ++a)
#pragma unroll
        for (int b = 0; b < 2; ++b)
#pragma unroll
            for (int m = 0; m < 4; ++m)
#pragma unroll
                for (int n = 0; n < 2; ++n) acc[a][b][m][n] = (f32x4){0.f, 0.f, 0.f, 0.f};
    bf16x8 At[4][2], B0[2][2], B1[2][2];
    const char* cA = (const char*)g.A + (size_t)cur.pm * tstep; const char* cB = (const char*)g.Bt + (size_t)cur.pn * tstep;
    S.a_ready(cur);
    if constexpr (SP2) {
        PG8_STAGE(PG8_SB(0, 0), cB, voffB); PG8_STAGE(PG8_SB(0, 1), cB + hstep, voffB); PG8_STAGE(PG8_SA(0, 0), cA, voffA); PG8_STAGE(PG8_SA(0, 1), cA + hstep, voffA);
        if (wr == 1) PG8_BAR;
        PG8_WAIT_V(2); PG8_BAR;
        PG8_STAGE(PG8_SB(1, 0), cB + kstep, voffB); PG8_STAGE(PG8_SA(1, 0), cA + kstep, voffA); PG8_STAGE(PG8_SB(1, 1), cB + hstep + kstep, voffB);
        PG8_WAIT_V(6); PG8_BAR;
    } else {
        PG8_STAGE(PG8_SB(0, 0), cB, voffB); PG8_STAGE(PG8_SA(0, 0), cA, voffA); PG8_STAGE(PG8_SB(0, 1), cB + hstep, voffB); PG8_STAGE(PG8_SA(0, 1), cA + hstep, voffA);
        if (wr == 1) PG8_BAR;
        PG8_WAIT_V(4); PG8_BAR;
        PG8_STAGE(PG8_SB(1, 0), cB + kstep, voffB); PG8_STAGE(PG8_SA(1, 0), cA + kstep, voffA); PG8_STAGE(PG8_SB(1, 1), cB + hstep + kstep, voffB);
        PG8_WAIT_V(6); PG8_BAR;
    }
    for (;;) {
        const bool has_next = S.next(ui + 1, nxt);
        const char* nA = has_next ? (const char*)g.A + (size_t)nxt.pm * tstep : cA; const char* nB = has_next ? (const char*)g.Bt + (size_t)nxt.pn * tstep : cB;
        for (int t = 0; t < nt; t += 2) {
            const bool last = (t == nt - 2);
            const char* a1 = cA + (size_t)(t + 1) * kstep;
            const char* a2 = last ? nA : cA + (size_t)(t + 2) * kstep; const char* b2 = last ? nB : cB + (size_t)(t + 2) * kstep;
            const char* a3 = a2 + kstep; const char* b3 = b2 + kstep;
            if (last && has_next) S.a_ready(nxt);
            if constexpr (SP2) {
            PG8_LDB(B0, 0, 0); PG8_LDB(B1, 0, 1); PG8_SCHED; PG8_LDA(At, 0, 0); PG8_STAGE(PG8_SA(1, 1), a1 + hstep, voffA);
            PG8_WAIT_V(8); PG8_WAIT_L(0); PG8_BAR; PG8_MMA(0, 0, At, B0); PG8_MMA(0, 1, At, B1); PG8_BAR; PG8_SCHED;
            PG8_LDA(At, 0, 1); PG8_STAGE(PG8_SB(0, 0), b2, voffB); PG8_STAGE(PG8_SB(0, 1), b2 + hstep, voffB); PG8_STAGE(PG8_SA(0, 0), a2, voffA);
            PG8_WAIT_V(8); PG8_WAIT_L(0); PG8_BAR; PG8_MMA(1, 0, At, B0); PG8_MMA(1, 1, At, B1); PG8_BAR; PG8_SCHED;
            PG8_LDB(B0, 1, 0); PG8_LDB(B1, 1, 1); PG8_SCHED; PG8_LDA(At, 1, 0); PG8_STAGE(PG8_SA(0, 1), a2 + hstep, voffA);
            PG8_WAIT_V(8); PG8_WAIT_L(0); PG8_BAR; PG8_MMA(0, 0, At, B0); PG8_MMA(0, 1, At, B1); PG8_BAR; PG8_SCHED;
            PG8_LDA(At, 1, 1); PG8_STAGE(PG8_SB(1, 0), b3, voffB); PG8_STAGE(PG8_SB(1, 1), b3 + hstep, voffB); PG8_STAGE(PG8_SA(1, 0), a3, voffA);
            PG8_WAIT_V(8); PG8_WAIT_L(0); PG8_BAR; PG8_MMA(1, 0, At, B0); PG8_MMA(1, 1, At, B1); PG8_BAR; PG8_SCHED;
            } else {
            PG8_LDB(B0, 0, 0); PG8_SCHED; PG8_LDA(At, 0, 0); PG8_STAGE(PG8_SA(1, 1), a1 + hstep, voffA);
            PG8_WAIT_L(8); PG8_BAR; PG8_WAIT_L(0); PG8_MMA(0, 0, At, B0); PG8_BAR; PG8_SCHED;
            PG8_LDB(B1, 0, 1); PG8_STAGE(PG8_SB(0, 0), b2, voffB);
            PG8_BAR; PG8_WAIT_L(0); PG8_MMA(0, 1, At, B1); PG8_BAR;
            PG8_LDA(At, 0, 1); PG8_STAGE(PG8_SA(0, 0), a2, voffA);
            PG8_BAR; PG8_WAIT_L(0); PG8_MMA(1, 0, At, B0); PG8_BAR; PG8_SCHED;
            PG8_STAGE(PG8_SB(0, 1), b2 + hstep, voffB);
            PG8_WAIT_V(6); PG8_BAR; PG8_MMA(1, 1, At, B1); PG8_BAR;
            PG8_LDB(B0, 1, 0); PG8_SCHED; PG8_LDA(At, 1, 0); PG8_STAGE(PG8_SA(0, 1), a2 + hstep, voffA);
            PG8_WAIT_L(8); PG8_BAR; PG8_WAIT_L(0); PG8_MMA(0, 0, At, B0); PG8_BAR; PG8_SCHED;
            PG8_LDB(B1, 1, 1); PG8_STAGE(PG8_SB(1, 0), b3, voffB);
            PG8_BAR; PG8_WAIT_L(0); PG8_MMA(0, 1, At, B1); PG8_BAR;
            PG8_LDA(At, 1, 1); PG8_STAGE(PG8_SA(1, 0), a3, voffA);
            PG8_BAR; PG8_WAIT_L(0); PG8_MMA(1, 0, At, B0); PG8_BAR; PG8_SCHED;
            PG8_STAGE(PG8_SB(1, 1), b3 + hstep, voffB);
            PG8_WAIT_V(6); PG8_BAR; PG8_MMA(1, 1, At, B1); PG8_BAR;
            }
        }
        if constexpr (ALIGN_EPI) { if (wr == 0) PG8_BAR; }
        if constexpr (!Epi::AFTER_DRAIN) { E(acc, cur, wr, wc, fr, fq); S.done(cur); }
        if (!has_next) break;
#pragma unroll
        for (int a = 0; a < 2; ++a)
#pragma unroll
            for (int b = 0; b < 2; ++b)
#pragma unroll
                for (int m = 0; m < 4; ++m)
#pragma unroll
                    for (int n = 0; n < 2; ++n) acc[a][b][m][n] = (f32x4){0.f, 0.f, 0.f, 0.f};
        cur = nxt; cA = nA; cB = nB; ++ui;
        if constexpr (ALIGN_EPI) { if (wr == 1) PG8_BAR; }
    }
    PG8_WAIT_V(0);
    if constexpr (!ALIGN_EPI) { if (wr == 0) PG8_BAR; }
    PG8_BAR;
    if constexpr (Epi::AFTER_DRAIN) { E.fused(acc, cur, wr, wc, fr, fq, lds, wid, lane); S.done(cur); }
#undef PG8_SA
#undef PG8_SB
#undef PG8_STAGE
#undef PG8_LDA
#undef PG8_LDB
#undef PG8_MMA
#undef PG8_WAIT_V
#undef PG8_WAIT_L
#undef PG8_BAR
#undef PG8_SCHED
}
}

#define LAS __attribute__((address_space(3)))
using pg8::bf16_t; using pg8::bf16x8; using pg8::f32x4; using pg8::u32x4;
typedef unsigned u32x2 __attribute__((ext_vector_type(2)));
typedef LAS unsigned char* ldsp;

constexpr int S_ = 16384, D_ = 1024, DFF = 2816, NGU = 5632;
constexpr int LDHA = 3584, QMA = 3328, LDHB = 512, QMB = 256;
constexpr int NTHREADS = 512, NW = 8;
constexpr int LDS_BYTES = 147456, XB_LDS_OFF = 147200;
constexpr float EPS = 1e-6f;

constexpr size_t MiB = 1u << 20;
constexpr size_t WS_CTL = 0, WS_TAB = 2048, WS_XBAR = 16384, CTL_ZERO_BYTES = 32768, WS_ROPE = 1 * MiB, WS_MEMN = 5 * MiB, WS_MEMK = 5 * MiB + 512 * 1024, WS_MEMVT = 5 * MiB + 640 * 1024;
constexpr size_t WS_DKVT = 6 * MiB, WS_UKT = 7 * MiB, WS_UVT = 7 * MiB + 384 * 1024;
constexpr size_t WS_W = 8 * MiB, WS_X = 54 * MiB, WS_XN = 118 * MiB, WS_KCAT = 150 * MiB, WS_VT = 186 * MiB;
constexpr size_t WS_HA = 150 * MiB, WS_NEGW = 262 * MiB, WS_QD = 286 * MiB, WS_KDT = 310 * MiB, WS_QK = 334 * MiB, WS_UT = 346 * MiB, WS_DCH = 370 * MiB;
constexpr size_t WS_H = 210 * MiB, WS_HB = 210 * MiB, WS_CQN = 226 * MiB, WS_QCAT = 234 * MiB;
constexpr size_t WS_MIX = 54 * MiB;
constexpr size_t WS_XG2 = 298 * MiB;
constexpr size_t WS_SSQ = 371 * MiB;
constexpr size_t WS_SQQ = 384 * MiB;
constexpr size_t WS_END = 385 * MiB;
constexpr size_t WO_GU1 = 0, WO_D1 = 5767168, WO_GU2 = 8650752, WO_D2 = 14417920, WO_OUT = 17301504, WO_MKV = 18350080, WO_IN = 18874368, WO_UQ = 19398656;

#define GAS __attribute__((address_space(1)))
__device__ __forceinline__ const float* gptr(const float* const* slot) { const unsigned long long v = *(const unsigned long long*)slot; return (const float*)(GAS const float*)v; }
struct Params { const float* in[26]; float* out; unsigned char* ws; float invf[32]; };

typedef float f32x2_t __attribute__((ext_vector_type(2))); typedef __bf16 bf16x2_t __attribute__((ext_vector_type(2)));
__device__ __forceinline__ unsigned pk2(float lo, float hi) { f32x2_t v = {lo, hi}; bf16x2_t b = __builtin_convertvector(v, bf16x2_t); return __builtin_bit_cast(unsigned, b); }
__device__ __forceinline__ float bf2f(unsigned short b) { return __uint_as_float(((unsigned)b) << 16); }
__device__ __forceinline__ float bflo(unsigned w) { return __uint_as_float(w << 16); }
__device__ __forceinline__ float bfhi(unsigned w) { return __uint_as_float(w & 0xffff0000u); }
__device__ __forceinline__ float wave_sum(float v) {
#pragma unroll
    for (int o = 1; o < 64; o <<= 1) v += __shfl_xor(v, o);
    return v;
}
__device__ __forceinline__ f32x4 mma(bf16x8 x, bf16x8 y, f32x4 c) { return __builtin_amdgcn_mfma_f32_16x16x32_bf16(x, y, c, 0, 0, 0); }
__device__ __forceinline__ float silu_f(float v) { return v * __builtin_amdgcn_rcpf(1.f + __builtin_amdgcn_exp2f(v * -1.4426950408889634f)); }
__device__ __forceinline__ int swzA(int r, int ch) { return r * 256 + ((ch ^ (r & 15)) << 4); }
__device__ __forceinline__ int swzB(int r, int ch) { return r * 128 + ((ch ^ (r & 7)) << 4); }
__device__ __forceinline__ bf16x8 ldsfrag(ldsp p) { return *(LAS bf16x8*)p; }
__device__ __forceinline__ bf16x8 gfrag(const bf16_t* p) { return *(const bf16x8*)p; }
__device__ __forceinline__ bf16x8 pack8(f32x4 a, f32x4 b) { u32x4 w; w.x = pk2(a[0], a[1]); w.y = pk2(a[2], a[3]); w.z = pk2(b[0], b[1]); w.w = pk2(b[2], b[3]); return __builtin_bit_cast(bf16x8, w); }
__device__ __forceinline__ u32x2 pack4(f32x4 a) { u32x2 w; w.x = pk2(a[0], a[1]); w.y = pk2(a[2], a[3]); return w; }

__device__ __forceinline__ float row_rstd(const float* ssq, int row, int fq) {
    const f32x4 pv = *(const f32x4*)(ssq + (size_t)row * 16 + 4 * fq);
    float s = (pv[0] + pv[1]) + (pv[2] + pv[3]);
    s += __shfl_xor(s, 16); s += __shfl_xor(s, 32);
    return rsqrtf(s * (1.f / D_) + EPS);
}
__device__ __forceinline__ void row_rstd8(const float* ssq, int row0, int fq, float (&r8)[2][4]) {
    f32x4 pv[2][4];
#pragma unroll
    for (int ai = 0; ai < 2; ++ai)
#pragma unroll
        for (int m = 0; m < 4; ++m) pv[ai][m] = *(const f32x4*)(ssq + (size_t)(row0 + ai * 128 + m * 16) * 16 + 4 * fq);
#pragma unroll
    for (int ai = 0; ai < 2; ++ai)
#pragma unroll
        for (int m = 0; m < 4; ++m) { float s = (pv[ai][m][0] + pv[ai][m][1]) + (pv[ai][m][2] + pv[ai][m][3]);
            s += __shfl_xor(s, 16); s += __shfl_xor(s, 32); r8[ai][m] = rsqrtf(s * (1.f / D_) + EPS); }
}
struct EpiSwiglu {
    static constexpr bool PERM = true, AFTER_DRAIN = false; bf16_t* H; const float* ssq;
    __device__ __forceinline__ void operator()(const f32x4 (&acc)[2][2][4][2], const pg8::Unit& u, int wr, int wc, int fr, int fq) const {
        const int row0 = u.pm * 256 + wr * 64 + fr, col = u.pn * 128 + wc * 32 + 8 * fq;
        float r8[2][4]; row_rstd8(ssq, row0, fq, r8);
#pragma unroll
        for (int ai = 0; ai < 2; ++ai)
#pragma unroll
            for (int m = 0; m < 4; ++m) {
                const float r = r8[ai][m];
                const f32x4 g0 = acc[ai][0][m][0] * r, g1 = acc[ai][0][m][1] * r, u0 = acc[ai][1][m][0] * r, u1 = acc[ai][1][m][1] * r;
                u32x4 w;
                w.x = pk2(silu_f(g0[0]) * u0[0], silu_f(g0[1]) * u0[1]); w.y = pk2(silu_f(g0[2]) * u0[2], silu_f(g0[3]) * u0[3]);
                w.z = pk2(silu_f(g1[0]) * u1[0], silu_f(g1[1]) * u1[1]); w.w = pk2(silu_f(g1[2]) * u1[2], silu_f(g1[3]) * u1[3]);
                *(u32x4*)(H + (size_t)(row0 + ai * 128 + m * 16) * DFF + col) = w;
            }
    }
};
struct EpiResid {
    static constexpr bool PERM = false, AFTER_DRAIN = false; bf16_t* xb; float scale; float* ssq;
    __device__ __forceinline__ void operator()(const f32x4 (&acc)[2][2][4][2], const pg8::Unit& u, int wr, int wc, int fr, int fq) const {
        const int row0 = u.pm * 256 + wr * 64 + fr, col0 = u.pn * 256 + wc * 32 + 4 * fq;
#pragma unroll
        for (int ai = 0; ai < 2; ++ai)
#pragma unroll
            for (int m = 0; m < 4; ++m) {
                const int row = row0 + ai * 128 + m * 16;
                float sq = 0.f;
#pragma unroll
                for (int bj = 0; bj < 2; ++bj)
#pragma unroll
                    for (int n = 0; n < 2; ++n) {
                        const size_t off = (size_t)row * D_ + col0 + bj * 128 + n * 16;
                        const u32x2 b = *(const u32x2*)(xb + off);
                        const f32x4 a = acc[ai][bj][m][n];
                        u32x2 w; w.x = pk2(bflo(b.x) + a[0] * scale, bfhi(b.x) + a[1] * scale); w.y = pk2(bflo(b.y) + a[2] * scale, bfhi(b.y) + a[3] * scale);
                        *(u32x2*)(xb + off) = w;
                        const float y0 = bflo(w.x), y1 = bfhi(w.x), y2 = bflo(w.y), y3 = bfhi(w.y);
                        sq += (y0 * y0 + y1 * y1) + (y2 * y2 + y3 * y3);
                    }
                sq += __shfl_xor(sq, 16); sq += __shfl_xor(sq, 32);
                if (fq == 0) ssq[(size_t)row * 16 + u.pn * 4 + wc] = sq;
            }
    }
};
template <bool P> struct EpiStore {
    static constexpr bool PERM = P, AFTER_DRAIN = false; bf16_t* O; int ldc; const float* ssq;
    __device__ __forceinline__ void operator()(const f32x4 (&acc)[2][2][4][2], const pg8::Unit& u, int wr, int wc, int fr, int fq) const {
        const int row0 = u.pm * 256 + wr * 64 + fr, col0 = u.pn * 256 + wc * 32 + 8 * fq;
        float r8[2][4];
        if (ssq) row_rstd8(ssq, row0, fq, r8);
#pragma unroll
        for (int ai = 0; ai < 2; ++ai)
#pragma unroll
            for (int m = 0; m < 4; ++m) {
                const float r = ssq ? r8[ai][m] : 1.f;
#pragma unroll
                for (int bj = 0; bj < 2; ++bj) {
                    u32x4 w; const f32x4 a = acc[ai][bj][m][0] * r, b = acc[ai][bj][m][1] * r;
                    w.x = pk2(a[0], a[1]); w.y = pk2(a[2], a[3]); w.z = pk2(b[0], b[1]); w.w = pk2(b[2], b[3]);
                    *(u32x4*)(O + (size_t)(row0 + ai * 128 + m * 16) * ldc + col0 + bj * 128) = w;
                }
            }
    }
};
struct EpiInB {
    static constexpr bool PERM = true, AFTER_DRAIN = false; bf16_t* HB; bf16_t* CQ; const float* ssq; float* sqq;
    __device__ __forceinline__ void operator()(const f32x4 (&acc)[2][2][4][2], const pg8::Unit& u, int wr, int wc, int fr, int fq) const {
        const int row0 = u.pm * 256 + wr * 64 + fr, cw = wc * 32 + 8 * fq;
        float r8[2][4]; row_rstd8(ssq, row0, fq, r8);
#pragma unroll
        for (int ai = 0; ai < 2; ++ai)
#pragma unroll
            for (int m = 0; m < 4; ++m) {
                const int row = row0 + ai * 128 + m * 16;
                const float r = r8[ai][m];
                float sq = 0.f;
#pragma unroll
                for (int bj = 0; bj < 2; ++bj) {
                    u32x4 w; const f32x4 a = acc[ai][bj][m][0] * r, b = acc[ai][bj][m][1] * r;
                    w.x = pk2(a[0], a[1]); w.y = pk2(a[2], a[3]); w.z = pk2(b[0], b[1]); w.w = pk2(b[2], b[3]);
                    if (u.pn == 0) {
                        *(u32x4*)(CQ + (size_t)row * 256 + bj * 128 + cw) = w;
                        const float y0 = bflo(w.x), y1 = bfhi(w.x), y2 = bflo(w.y), y3 = bfhi(w.y), y4 = bflo(w.z), y5 = bfhi(w.z), y6 = bflo(w.w), y7 = bfhi(w.w);
                        sq += ((y0 * y0 + y1 * y1) + (y2 * y2 + y3 * y3)) + ((y4 * y4 + y5 * y5) + (y6 * y6 + y7 * y7));
                    } else *(u32x4*)(HB + (size_t)row * LDHB + 256 + bj * 128 + cw) = w;
                }
                if (u.pn == 0) { sq += __shfl_xor(sq, 16); sq += __shfl_xor(sq, 32); if (fq == 0) sqq[(size_t)row * 4 + wc] = sq; }
            }
    }
};
struct EpiKnope {
    static constexpr bool PERM = true, AFTER_DRAIN = false; bf16_t* K;
    __device__ __forceinline__ void operator()(const f32x4 (&acc)[2][2][4][2], const pg8::Unit& u, int wr, int wc, int fr, int fq) const {
        const int row0 = u.pm * 256 + wr * 64 + fr, d = wc * 32 + 8 * fq;
#pragma unroll
        for (int ai = 0; ai < 2; ++ai)
#pragma unroll
            for (int m = 0; m < 4; ++m)
#pragma unroll
                for (int bj = 0; bj < 2; ++bj) {
                    const int head = 2 * u.pn + bj;
                    u32x4 w; const f32x4 a = acc[ai][bj][m][0], b = acc[ai][bj][m][1];
                    w.x = pk2(a[0], a[1]); w.y = pk2(a[2], a[3]); w.z = pk2(b[0], b[1]); w.w = pk2(b[2], b[3]);
                    *(u32x4*)(K + ((size_t)head * S_ + row0 + ai * 128 + m * 16) * 192 + d) = w;
                }
    }
};
struct EpiQ {
    static constexpr bool PERM = true, AFTER_DRAIN = false; bf16_t* Q; const float2* tab; float qs; const float* sqq;
    __device__ __forceinline__ float rq(int row) const { const f32x4 s = *(const f32x4*)(sqq + (size_t)row * 4); return rsqrtf(((s[0] + s[1]) + (s[2] + s[3])) * (1.f / 256.f) + EPS) * qs; }
    __device__ __forceinline__ void operator()(const f32x4 (&acc)[2][2][4][2], const pg8::Unit& u, int wr, int wc, int fr, int fq) const {
        const int row0 = u.pm * 256 + wr * 64 + fr;
        if (u.pn < 3) {
            const int d = wc * 32 + 8 * fq;
#pragma unroll
            for (int ai = 0; ai < 2; ++ai)
#pragma unroll
                for (int m = 0; m < 4; ++m)
#pragma unroll
                    for (int bj = 0; bj < 2; ++bj) {
                        const int head = 2 * u.pn + bj;
                        u32x4 w; const f32x4 a = acc[ai][bj][m][0] * rq(row0 + ai * 128 + m * 16), b = acc[ai][bj][m][1] * rq(row0 + ai * 128 + m * 16);
                        w.x = pk2(a[0], a[1]); w.y = pk2(a[2], a[3]); w.z = pk2(b[0], b[1]); w.w = pk2(b[2], b[3]);
                        *(u32x4*)(Q + ((size_t)(row0 + ai * 128 + m * 16) * 6 + head) * 192 + d) = w;
                    }
        } else {
            const int head = 4 * (u.pn - 3) + wc;
            if (head < 6) {
#pragma unroll
                for (int ai = 0; ai < 2; ++ai)
#pragma unroll
                    for (int m = 0; m < 4; ++m) {
                        const int row = row0 + ai * 128 + m * 16;
                        float o1[8], o2[8]; const float qr = rq(row);
#pragma unroll
                        for (int n = 0; n < 2; ++n)
#pragma unroll
                            for (int j = 0; j < 4; ++j) {
                                const float2 cs = tab[(size_t)row * 32 + 8 * fq + 4 * n + j];
                                const float x1 = acc[ai][0][m][n][j], x2 = acc[ai][1][m][n][j];
                                o1[4 * n + j] = (x1 * cs.x - x2 * cs.y) * qr; o2[4 * n + j] = (x1 * cs.y + x2 * cs.x) * qr;
                            }
                        u32x4 w1, w2;
                        w1.x = pk2(o1[0], o1[1]); w1.y = pk2(o1[2], o1[3]); w1.z = pk2(o1[4], o1[5]); w1.w = pk2(o1[6], o1[7]);
                        w2.x = pk2(o2[0], o2[1]); w2.y = pk2(o2[2], o2[3]); w2.z = pk2(o2[4], o2[5]); w2.w = pk2(o2[6], o2[7]);
                        bf16_t* qp = Q + ((size_t)row * 6 + head) * 192 + 128 + 8 * fq;
                        *(u32x4*)qp = w1; *(u32x4*)(qp + 32) = w2;
                    }
            }
        }
    }
};

template <class Epi> __device__ __forceinline__ void run_gemm(ldsp lds, const bf16_t* A, const bf16_t* Bt, int M, int N, int K, int c, const Epi& E) {
    asm volatile("" : "+s"(M), "+s"(N), "+s"(K), "+s"(c));
    pg8::Gemm g{A, Bt, M, N, K}; pg8::StaticOrder S; S.init(M, N, (int)gridDim.x, c);
    pg8::gemm_phase<Epi, pg8::StaticOrder, true, false>(lds, g, S, E);
}

__device__ __forceinline__ int wmap(int map, int n, int nsrc) {
    switch (map) {
    case 0: return n < nsrc ? n : -1;
    case 1: { const int t = n >> 8, w = n & 255; return (w >> 7) * DFF + t * 128 + (w & 127); }
    case 2: { if (n < 768) return (n >> 7) * 192 + (n & 127);
              const int m = n - 768, t = m >> 8, w = m & 255, bj = w >> 7, cc = w & 127, head = 4 * t + (cc >> 5), jj = cc & 31;
              return head < 6 ? head * 192 + 128 + bj * 32 + jj : -1; }
    case 3: return n < 3084 ? n : (n >= QMA ? n - QMA + 3084 : -1);
    case 4: return (n >> 7) * 256 + (n & 127);
    default: return (n >> 7) * 256 + 128 + (n & 127);
    }
}
__device__ __forceinline__ void conv_job(const float* W, int K, int Nsrc, int Nout, int map, bf16_t* WT, LAS float* scr, int gw, int ngw, int lane, const float* gk = nullptr) {
    const int nblk = Nout / 32, nitems = (K / 64) * nblk;
    for (int it = gw; it < nitems; it += ngw) {
        const int kb = it / nblk, nb = it % nblk, k0 = 64 * kb, n0 = 32 * nb;
        const int sc = wmap(map, n0 + (lane & 31), Nsrc);
        float wv[32];
#pragma unroll
        for (int i = 0; i < 32; ++i) { const int kk = 2 * i + (lane >> 5); wv[i] = sc >= 0 ? W[(size_t)(k0 + kk) * Nsrc + sc] : 0.f; }
        if (gk) {
#pragma unroll
            for (int i = 0; i < 32; ++i) wv[i] *= gk[k0 + 2 * i + (lane >> 5)];
        }
#pragma unroll
        for (int i = 0; i < 32; ++i) { const int kk = 2 * i + (lane >> 5); scr[kk * 33 + (lane & 31)] = wv[i]; }
        asm volatile("s_waitcnt lgkmcnt(0)" ::: "memory");
        const int c = lane & 7;
#pragma unroll
        for (int j = 0; j < 4; ++j) { const int n = (lane >> 3) + 8 * j; const LAS float* s = scr + (8 * c) * 33 + n;
            u32x4 o; o.x = pk2(s[0 * 33], s[1 * 33]); o.y = pk2(s[2 * 33], s[3 * 33]); o.z = pk2(s[4 * 33], s[5 * 33]); o.w = pk2(s[6 * 33], s[7 * 33]);
            *(u32x4*)(WT + (size_t)(n0 + n) * K + k0 + 8 * c) = o; }
        asm volatile("s_waitcnt lgkmcnt(0)" ::: "memory");
    }
}
__device__ __forceinline__ void conv_group(const float* const* tin, unsigned char* wsb, int l, int group, ldsp lds, int gw, int ngw, int lane, int wid) {
    LAS float* scr = (LAS float*)(lds + wid * 16384);
    bf16_t* W = (bf16_t*)(wsb + WS_W);
    if (group == 0) {
        conv_job(gptr(tin + 4) + (size_t)l * D_ * NGU, D_, NGU, NGU, 1, W + WO_GU1, scr, gw, ngw, lane, gptr(tin + 3) + l * D_);
        conv_job(gptr(tin + 12) + (size_t)l * D_ * 512, D_, 512, 512, 0, W + WO_MKV, scr, gw, ngw, lane);
    } else if (group == 1) {
        conv_job(gptr(tin + 5) + (size_t)l * DFF * D_, DFF, D_, D_, 0, W + WO_D1, scr, gw, ngw, lane);
        if (l < 2) conv_job(gptr(tin + 13) + (size_t)l * D_ * 3340, D_, 3340, LDHA, 3, W + WO_IN, scr, gw, ngw, lane, gptr(tin + 6) + l * D_);
        else { conv_job(gptr(tin + 18) + (size_t)(l - 2) * D_ * 512, D_, 512, 512, 0, W + WO_IN, scr, gw, ngw, lane, gptr(tin + 6) + l * D_);
               conv_job(gptr(tin + 20) + (size_t)(l - 2) * 256 * 1152, 256, 1152, 1280, 2, W + WO_UQ, scr, gw, ngw, lane, gptr(tin + 19) + (l - 2) * 256); }
        conv_job(gptr(tin + 10) + (size_t)l * D_ * D_, D_, D_, D_, 0, W + WO_OUT, scr, gw, ngw, lane);
    } else {
        conv_job(gptr(tin + 8) + (size_t)l * D_ * NGU, D_, NGU, NGU, 1, W + WO_GU2, scr, gw, ngw, lane, gptr(tin + 7) + l * D_);
        conv_job(gptr(tin + 9) + (size_t)l * DFF * D_, DFF, D_, D_, 0, W + WO_D2, scr, gw, ngw, lane);
    }
}

__device__ __forceinline__ void rms_row_bf16(const float* xrow, const float* g, bf16_t* orow, int lane) {
    f32x4 v[4]; float s = 0.f;
#pragma unroll
    for (int j = 0; j < 4; ++j) { v[j] = *(const f32x4*)(xrow + 4 * lane + 256 * j); s += (v[j][0] * v[j][0] + v[j][1] * v[j][1]) + (v[j][2] * v[j][2] + v[j][3] * v[j][3]); }
    const float r = rsqrtf(wave_sum(s) * (1.f / D_) + EPS);
#pragma unroll
    for (int j = 0; j < 4; ++j) { const f32x4 gg = *(const f32x4*)(g + 4 * lane + 256 * j);
        u32x2 w; w.x = pk2(v[j][0] * r * gg[0], v[j][1] * r * gg[1]); w.y = pk2(v[j][2] * r * gg[2], v[j][3] * r * gg[3]);
        *(u32x2*)(orow + 4 * lane + 256 * j) = w; }
}
__device__ __forceinline__ void norm_rows(const float* x, const float* g, bf16_t* xn, int nrows, int gw, int ngw, int lane) {
    for (int m = gw; m < nrows; m += ngw) rms_row_bf16(x + (size_t)m * D_, g, xn + (size_t)m * D_, lane);
}

template <int I> struct SolveRow {
    static __device__ __forceinline__ void run(float (&t)[64], const float (&a)[64], float lanef) {
        SolveRow<I - 1>::run(t, a, lanef);
        float s0 = __builtin_amdgcn_fmed3f(1.f - fabsf(lanef - (float)I), 0.f, 1.f), s1 = 0.f, s2 = 0.f, s3 = 0.f;
        const int ai = __float_as_int(a[I]);
#pragma unroll
        for (int j = 0; j < I; ++j) {
            const float aj = __int_as_float(__builtin_amdgcn_readlane(ai, j));
            if ((j & 3) == 0) s0 -= aj * t[j]; else if ((j & 3) == 1) s1 -= aj * t[j]; else if ((j & 3) == 2) s2 -= aj * t[j]; else s3 -= aj * t[j];
        }
        t[I] = (s0 + s1) + (s2 + s3);
    }
};
template <> struct SolveRow<0> { static __device__ __forceinline__ void run(float (&)[64], const float (&)[64], float) {} };
constexpr int PL_AS = 0, PL_TINV = 16384, PL_GC = 24576, PL_BETA = 24832, PL_QS = 32768, PL_KS = 49152, PL_KTS = 65536, PL_VTS = 81920;
__device__ __forceinline__ void gdn_prep_unit(ldsp L, int u, const bf16_t* hA, const float* convw, float Aexp, float dtb,
                                             bf16_t* negw, bf16_t* qd, bf16_t* kdT, bf16_t* qk, bf16_t* uT, float* dch, int tid, int wid, int lane) {
    const int n = u / 6, h = u - 6 * n, t0 = 64 * n, fr = lane & 15, fq = lane >> 4;
    const int us = h * 256 + n;
    LAS float* GC = (LAS float*)(L + PL_GC); LAS float* BETA = (LAS float*)(L + PL_BETA); LAS float* AS = (LAS float*)(L + PL_AS);
    float beta, gc, glast;
    {
        const bf16_t* rowp = hA + (size_t)(t0 + lane) * LDHA;
        const float braw = bf2f(rowp[3072 + h]), araw = bf2f(rowp[3078 + h]);
        beta = 1.f / (1.f + __expf(-braw));
        const float xs = araw + dtb; const float sp = xs > 20.f ? xs : log1pf(__expf(xs));
        gc = -Aexp * sp;
#pragma unroll
        for (int o = 1; o < 64; o <<= 1) { const float t = __shfl_up(gc, o); if (lane >= o) gc += t; }
        glast = __shfl(gc, 63);
        if (wid == 0) { GC[lane] = gc; BETA[lane] = beta; }
    }
#pragma unroll
    for (int tt = 0; tt < 3; ++tt) {
        const int cb = tt * 768 + h * 128 + 2 * lane;
        float w0[4], w1[4];
#pragma unroll
        for (int k = 0; k < 4; ++k) { const float2 wv = *(const float2*)(convw + k * 2304 + cb); w0[k] = wv.x; w1[k] = wv.y; }
        float x0[11], x1[11];
#pragma unroll
        for (int r = 0; r < 11; ++r) { const int row = t0 + 8 * wid - 3 + r; unsigned v = 0u; if (row >= 0) v = *(const unsigned*)(hA + (size_t)row * LDHA + cb); x0[r] = bflo(v); x1[r] = bfhi(v); }
#pragma unroll
        for (int i = 0; i < 8; ++i) {
            float a0 = 0.f, a1 = 0.f;
#pragma unroll
            for (int k = 0; k < 4; ++k) { a0 += w0[k] * x0[i + k]; a1 += w1[k] * x1[i + k]; }
            a0 = silu_f(a0); a1 = silu_f(a1);
            const int il = 8 * wid + i;
            const float bi = __shfl(beta, il), gi = __shfl(gc, il);
            if (tt < 2) {
                const float ss = wave_sum(a0 * a0 + a1 * a1);
                float rn = rsqrtf(ss + EPS); if (tt == 0) rn *= 0.08838834764831845f;
                a0 *= rn; a1 *= rn;
                *(LAS unsigned*)(L + (tt == 0 ? PL_QS : PL_KS) + swzA(il, lane >> 2) + (lane & 3) * 4) = pk2(a0, a1);
                if (tt == 1) { const float sc = bi * __expf(gi); const unsigned w = pk2(a0 * sc, a1 * sc);
                    *(LAS bf16_t*)(L + PL_KTS + swzB(2 * lane, il >> 3) + (il & 7) * 2) = (bf16_t)(w & 0xffffu);
                    *(LAS bf16_t*)(L + PL_KTS + swzB(2 * lane + 1, il >> 3) + (il & 7) * 2) = (bf16_t)(w >> 16); }
            } else {
                const unsigned w = pk2(a0 * bi, a1 * bi);
                *(LAS bf16_t*)(L + PL_VTS + swzB(2 * lane, il >> 3) + (il & 7) * 2) = (bf16_t)(w & 0xffffu);
                *(LAS bf16_t*)(L + PL_VTS + swzB(2 * lane + 1, il >> 3) + (il & 7) * 2) = (bf16_t)(w >> 16);
            }
        }
    }
    __syncthreads();
#pragma unroll
    for (int pp = 0; pp < 2; ++pp) {
        const int pr = wid + 8 * pp, it = pr >> 2, jt = pr & 3;
        f32x4 accA = {0.f, 0.f, 0.f, 0.f}, accQ = {0.f, 0.f, 0.f, 0.f};
        if (jt <= it) {
#pragma unroll
            for (int s = 0; s < 4; ++s) {
                const bf16x8 X = ldsfrag(L + PL_KS + swzA(16 * jt + fr, 4 * s + fq));
                const bf16x8 Yk = ldsfrag(L + PL_KS + swzA(16 * it + fr, 4 * s + fq));
                const bf16x8 Yq = ldsfrag(L + PL_QS + swzA(16 * it + fr, 4 * s + fq));
                accA = mma(X, Yk, accA); accQ = mma(X, Yq, accQ);
            }
        }
        const int i = 16 * it + fr; const float gci = GC[i], bi = BETA[i];
        f32x4 av, qv;
#pragma unroll
        for (int r = 0; r < 4; ++r) { const int j = 16 * jt + 4 * fq + r; const float dec = __expf(gci - GC[j]);
            av[r] = (j < i) ? bi * accA[r] * dec : 0.f; qv[r] = (j <= i) ? accQ[r] * dec : 0.f; }
        if (jt <= it) *(LAS f32x4*)(AS + i * 64 + 16 * jt + 4 * fq) = av;
        *(u32x2*)(qk + (size_t)us * 4096 + i * 64 + 32 * (jt >> 1) + 8 * fq + 4 * (jt & 1)) = pack4(qv);
    }
    __syncthreads();
    if (wid == 0) {
        float t[64]; const float lanef = (float)lane;
        unsigned asb_ = (unsigned)(uintptr_t)(L + PL_AS); asm volatile("" : "+v"(asb_)); const ldsp asb = (ldsp)asb_;
#pragma unroll
        for (int i = 0; i < 64; ++i) t[i] = 0.f;
        t[0] = __builtin_amdgcn_fmed3f(1.f - fabsf(lanef), 0.f, 1.f);
        float arow[64];
#pragma unroll
        for (int i = 0; i < 64; ++i) arow[i] = *(LAS float*)(asb + (i * 64) * 4 + lane * 4);
        SolveRow<63>::run(t, arow, lanef);
#pragma unroll
        for (int i = 0; i < 64; ++i) *(LAS bf16_t*)(L + PL_TINV + swzB(i, lane >> 3) + (lane & 7) * 2) = (bf16_t)(pk2(t[i], 0.f) & 0xffffu);
        if (lane == 0) dch[us] = __expf(glast);
    } else {
        const int t7 = tid - 64;
        for (int it = t7; it < 1024; it += 448) {
            const int c = it >> 4, oc = it & 15, s = oc >> 2, fqq = oc & 3, d1 = 32 * s + 4 * fqq, d2 = d1 + 16;
            const u32x2 a = *(LAS u32x2*)(L + PL_QS + swzA(c, d1 >> 3) + (d1 & 7) * 2), b = *(LAS u32x2*)(L + PL_QS + swzA(c, d2 >> 3) + (d2 & 7) * 2);
            const float e = __expf(GC[c]);
            u32x4 w; w.x = pk2(bflo(a.x) * e, bfhi(a.x) * e); w.y = pk2(bflo(a.y) * e, bfhi(a.y) * e); w.z = pk2(bflo(b.x) * e, bfhi(b.x) * e); w.w = pk2(bflo(b.y) * e, bfhi(b.y) * e);
            *(u32x4*)(qd + (size_t)us * 8192 + c * 128 + 8 * oc) = w;
        }
        for (int it = t7; it < 1024; it += 448) {
            const int d = it >> 3, oc = it & 7, s = oc >> 2, fqq = oc & 3;
            float v[8];
#pragma unroll
            for (int a = 0; a < 2; ++a)
#pragma unroll
                for (int b = 0; b < 4; ++b) { const int c = 32 * s + 16 * a + 4 * fqq + b;
                    v[4 * a + b] = bf2f(*(LAS bf16_t*)(L + PL_KS + swzA(c, d >> 3) + (d & 7) * 2)) * __expf(glast - GC[c]); }
            u32x4 w; w.x = pk2(v[0], v[1]); w.y = pk2(v[2], v[3]); w.z = pk2(v[4], v[5]); w.w = pk2(v[6], v[7]);
            *(u32x4*)(kdT + (size_t)us * 8192 + d * 64 + 8 * oc) = w;
        }
    }
    __syncthreads();
    {
        const int ct = wid >> 1;
        bf16x8 yt[2];
#pragma unroll
        for (int s2 = 0; s2 < 2; ++s2) yt[s2] = ldsfrag(L + PL_TINV + swzB(16 * ct + fr, 4 * s2 + fq));
#pragma unroll
        for (int q = 0; q < 4; ++q) {
            const int dt = 4 * (wid & 1) + q; f32x4 acc = {0.f, 0.f, 0.f, 0.f};
#pragma unroll
            for (int s2 = 0; s2 < 2; ++s2) acc = mma(ldsfrag(L + PL_KTS + swzB(16 * dt + fr, 4 * s2 + fq)), yt[s2], acc);
            acc = -acc;
            *(u32x2*)(negw + (size_t)us * 8192 + (16 * ct + fr) * 128 + 32 * (dt >> 1) + 8 * fq + 4 * (dt & 1)) = pack4(acc);
        }
        const int et = wid;
        bf16x8 yv[2];
#pragma unroll
        for (int s2 = 0; s2 < 2; ++s2) yv[s2] = ldsfrag(L + PL_VTS + swzB(16 * et + fr, 4 * s2 + fq));
#pragma unroll
        for (int c4 = 0; c4 < 4; ++c4) {
            f32x4 acc = {0.f, 0.f, 0.f, 0.f};
#pragma unroll
            for (int s2 = 0; s2 < 2; ++s2) acc = mma(ldsfrag(L + PL_TINV + swzB(16 * c4 + fr, 4 * s2 + fq)), yv[s2], acc);
            *(u32x2*)(uT + (size_t)us * 8192 + (16 * et + fr) * 64 + 16 * c4 + 4 * fq) = pack4(acc);
        }
    }
    __syncthreads();
}

constexpr int SC_BUF = 57344, SC_NEGW = 0, SC_QD = 16384, SC_KDT = 32768, SC_QK = 49152;
#define SCB() __builtin_amdgcn_sched_barrier(0)
__device__ __forceinline__ void scan_step(ldsp B, f32x4 (&S)[8], const u32x2 (&uc)[4], float dc, bf16_t* orow, int fr, int fq) {
    bf16x8 fa[8], fb[8];
    bf16x8 ys[4];
#pragma unroll
    for (int s = 0; s < 4; ++s) ys[s] = pack8(S[2 * s], S[2 * s + 1]);
    f32x4 vn[4], o[4];
#pragma unroll
    for (int ct = 0; ct < 4; ++ct) { vn[ct] = (f32x4){bflo(uc[ct].x), bfhi(uc[ct].x), bflo(uc[ct].y), bfhi(uc[ct].y)}; o[ct] = (f32x4){0.f, 0.f, 0.f, 0.f}; }
#define LD_P1(dst, s) do { _Pragma("unroll") for (int ct = 0; ct < 4; ++ct) { dst[ct] = ldsfrag(B + SC_NEGW + swzA(16 * ct + fr, 4 * (s) + fq)); dst[4 + ct] = ldsfrag(B + SC_QD + swzA(16 * ct + fr, 4 * (s) + fq)); } } while (0)
#define MM_P1(src, s) do { _Pragma("unroll") for (int ct = 0; ct < 4; ++ct) { vn[ct] = mma(src[ct], ys[s], vn[ct]); o[ct] = mma(src[4 + ct], ys[s], o[ct]); } } while (0)
#define LD_KD(dst, d0) do { _Pragma("unroll") for (int q = 0; q < 4; ++q) { dst[2 * q] = ldsfrag(B + SC_KDT + swzB(16 * ((d0) + q) + fr, fq)); dst[2 * q + 1] = ldsfrag(B + SC_KDT + swzB(16 * ((d0) + q) + fr, 4 + fq)); } } while (0)
#define MM_KD(src, d0) do { _Pragma("unroll") for (int q = 0; q < 4; ++q) { S[(d0) + q] = mma(src[2 * q], yv[0], S[(d0) + q]); } _Pragma("unroll") for (int q = 0; q < 4; ++q) { S[(d0) + q] = mma(src[2 * q + 1], yv[1], S[(d0) + q]); } } while (0)
    LD_P1(fa, 0); SCB();
    LD_P1(fb, 1); SCB(); MM_P1(fa, 0); SCB();
    LD_P1(fa, 2); SCB(); MM_P1(fb, 1); SCB();
    LD_P1(fb, 3); SCB(); MM_P1(fa, 2); SCB();
    LD_KD(fa, 0); SCB(); MM_P1(fb, 3); SCB();
#pragma unroll
    for (int dt = 0; dt < 8; ++dt) S[dt] = S[dt] * dc;
    LD_KD(fb, 4); SCB();
    bf16x8 yv[2];
#pragma unroll
    for (int s2 = 0; s2 < 2; ++s2) yv[s2] = pack8(vn[2 * s2], vn[2 * s2 + 1]);
    MM_KD(fa, 0); SCB();
#pragma unroll
    for (int ct = 0; ct < 4; ++ct) { fa[2 * ct] = ldsfrag(B + SC_QK + swzB(16 * ct + fr, fq)); fa[2 * ct + 1] = ldsfrag(B + SC_QK + swzB(16 * ct + fr, 4 + fq)); }
    SCB(); MM_KD(fb, 4); SCB();
#pragma unroll
    for (int ct = 0; ct < 4; ++ct) o[ct] = mma(fa[2 * ct], yv[0], o[ct]);
#pragma unroll
    for (int ct = 0; ct < 4; ++ct) o[ct] = mma(fa[2 * ct + 1], yv[1], o[ct]);
#pragma unroll
    for (int ct = 0; ct < 4; ++ct)
#pragma unroll
        for (int r = 0; r < 4; ++r) orow[(size_t)(16 * ct + 4 * fq + r) * LDHA] = (bf16_t)(pk2(o[ct][r], 0.f) & 0xffffu);
#undef LD_P1
#undef MM_P1
#undef LD_KD
#undef MM_KD
}
__device__ __forceinline__ void gdn_scan(ldsp L, int h, int eq, const bf16_t* negw, const bf16_t* qd, const bf16_t* kdT, const bf16_t* qk, const bf16_t* uT, const float* dch,
                                        bf16_t* hA, int tid, int wid, int lane) {
#define SC_BAR() asm volatile("s_waitcnt lgkmcnt(0)\n\ts_barrier" ::: "memory")
    const int fr = lane & 15, fq = lane >> 4, e0 = 32 * eq + 16 * wid;
    if (wid < 2) {
        f32x4 S[8];
#pragma unroll
        for (int d = 0; d < 8; ++d) S[d] = (f32x4){0.f, 0.f, 0.f, 0.f};
        u32x2 ua[4], ub[4]; float da, db;
#define SC_LOADU(un, dcn, nn) do { const size_t u_ = (size_t)h * 256 + (nn); \
        _Pragma("unroll") for (int ct = 0; ct < 4; ++ct) un[ct] = *(const u32x2*)(uT + u_ * 8192 + (size_t)(e0 + fr) * 64 + 16 * ct + 4 * fq); dcn = dch[u_]; } while (0)
        SC_LOADU(ua, da, 0); SC_LOADU(ub, db, 1);
        SC_BAR();
        for (int n = 0; n < 256; n += 2) {
            { u32x2 uc[4]; const float dc = da;
#pragma unroll
              for (int ct = 0; ct < 4; ++ct) uc[ct] = ua[ct];
              SC_LOADU(ua, da, (n + 2 < 256 ? n + 2 : 255));
              scan_step(L, S, uc, dc, hA + (size_t)(64 * n) * LDHA + h * 128 + e0 + fr, fr, fq);
              SC_BAR(); }
            { u32x2 uc[4]; const float dc = db;
#pragma unroll
              for (int ct = 0; ct < 4; ++ct) uc[ct] = ub[ct];
              SC_LOADU(ub, db, (n + 3 < 256 ? n + 3 : 255));
              scan_step(L + SC_BUF, S, uc, dc, hA + (size_t)(64 * (n + 1)) * LDHA + h * 128 + e0 + fr, fr, fq);
              SC_BAR(); }
        }
#undef SC_LOADU
    } else {
        const int w6 = wid - 2;
        u32x4 ra[10], rb[10];
#define SC_LOADS(r, nn) do { const size_t u_ = (size_t)h * 256 + (nn); \
        _Pragma("unroll") for (int i_ = 0; i_ < 10; ++i_) { const int idx_ = (w6 + 6 * i_) < 56 ? (w6 + 6 * i_) : 55; { const int a_ = idx_ >> 4, c_ = (idx_ & 15) * 64 + lane; \
            const bf16_t* b_ = a_ == 0 ? negw : a_ == 1 ? qd : a_ == 2 ? kdT : qk; \
            r[i_] = *(const u32x4*)(b_ + u_ * (a_ == 3 ? 4096 : 8192) + (size_t)c_ * 8); } } } while (0)
#define SC_STORES(r, buf) do { ldsp B_ = L + (buf) * SC_BUF; \
        _Pragma("unroll") for (int i_ = 0; i_ < 10; ++i_) { const int idx_ = (w6 + 6 * i_) < 56 ? (w6 + 6 * i_) : 55; { const int a_ = idx_ >> 4, c_ = (idx_ & 15) * 64 + lane; \
            const int off_ = a_ < 2 ? a_ * 16384 + swzA(c_ >> 4, c_ & 15) : (a_ == 2 ? SC_KDT : SC_QK) + swzB(c_ >> 3, c_ & 7); \
            *(LAS u32x4*)(B_ + off_) = r[i_]; } } } while (0)
        SC_LOADS(ra, 0); SC_STORES(ra, 0);
        SC_LOADS(rb, 1); SC_LOADS(ra, 2);
        SC_BAR();
        for (int n = 0; n < 256; n += 2) {
            SC_STORES(rb, 1);
            SC_LOADS(rb, (n + 3 < 256 ? n + 3 : 255));
            SC_BAR();
            SC_STORES(ra, 0);
            SC_LOADS(ra, (n + 4 < 256 ? n + 4 : 255));
            SC_BAR();
        }
#undef SC_LOADS
#undef SC_STORES
    }
}
#undef SC_BAR

__device__ __forceinline__ void gdn_out_rows(const bf16_t* hA, const float* gain, bf16_t* mix, int gw, int ngw, int lane) {
    const float2 gg = *(const float2*)(gain + 2 * lane);
    for (int m0 = gw; m0 < S_; m0 += 2 * ngw) {
        unsigned ov[2][6], gv[2][6];
#pragma unroll
        for (int q = 0; q < 2; ++q) {
            const int m = m0 + q * ngw < S_ ? m0 + q * ngw : m0;
            const bf16_t* rowp = hA + (size_t)m * LDHA;
#pragma unroll
            for (int h = 0; h < 6; ++h) { ov[q][h] = *(const unsigned*)(rowp + h * 128 + 2 * lane); gv[q][h] = *(const unsigned*)(rowp + 2304 + h * 128 + 2 * lane); }
        }
#pragma unroll
        for (int q = 0; q < 2; ++q) {
            const int m = m0 + q * ngw;
            if (m < S_) {
#pragma unroll
                for (int h = 0; h < 6; ++h) {
                    const float o0 = bflo(ov[q][h]), o1 = bfhi(ov[q][h]);
                    const float r = rsqrtf(wave_sum(o0 * o0 + o1 * o1) * (1.f / 128.f) + EPS);
                    *(unsigned*)(mix + (size_t)m * D_ + h * 128 + 2 * lane) = pk2(o0 * r * gg.x * silu_f(bflo(gv[q][h])), o1 * r * gg.y * silu_f(bfhi(gv[q][h])));
                }
            }
        }
    }
}

__device__ __forceinline__ int swzV(int r, int ch) { return r * 512 + ((ch ^ (r & 15)) << 4); }
__device__ __forceinline__ void mem_attn(ldsp L, const bf16_t* qsrc, int ldq, int qcol, const bf16_t* memK, const bf16_t* memVt, bf16_t* mix, int tid, int wid, int lane) {
    const int fr = lane & 15, fq = lane >> 4;
    const float SCL = 0.125f * 1.4426950408889634f;
    for (int unit = blockIdx.x; unit < 256; unit += gridDim.x) {
        const int hm = unit & 3, tb = unit >> 2;
#pragma unroll
        for (int i = 0; i < 4; ++i) { const int g = tid + 512 * i;
            *(LAS u32x4*)(L + swzB(g >> 3, g & 7)) = *(const u32x4*)(memK + (size_t)(g >> 3) * 256 + hm * 64 + (g & 7) * 8);
            *(LAS u32x4*)(L + 32768 + swzV(g >> 5, g & 31)) = *(const u32x4*)(memVt + (size_t)(hm * 64 + (g >> 5)) * 256 + (g & 31) * 8); }
        __syncthreads();
        for (int tl = wid; tl < 16; tl += NW) {
            const int tok0 = 256 * tb + 16 * tl;
            bf16x8 yq[2];
#pragma unroll
            for (int s = 0; s < 2; ++s) yq[s] = gfrag(qsrc + (size_t)(tok0 + fr) * ldq + qcol + hm * 64 + 32 * s + 8 * fq);
            f32x4 sc[16];
#pragma unroll
            for (int kb = 0; kb < 4; ++kb) {
                bf16x8 xk[8];
#pragma unroll
                for (int q = 0; q < 4; ++q) { xk[2 * q] = ldsfrag(L + swzB(16 * (4 * kb + q) + fr, fq)); xk[2 * q + 1] = ldsfrag(L + swzB(16 * (4 * kb + q) + fr, 4 + fq)); }
                SCB();
#pragma unroll
                for (int q = 0; q < 4; ++q) { sc[4 * kb + q] = mma(xk[2 * q], yq[0], (f32x4){0.f, 0.f, 0.f, 0.f}); sc[4 * kb + q] = mma(xk[2 * q + 1], yq[1], sc[4 * kb + q]); }
                SCB();
            }
            float mx = -1e30f;
#pragma unroll
            for (int kt = 0; kt < 16; ++kt)
#pragma unroll
                for (int r = 0; r < 4; ++r) mx = fmaxf(mx, sc[kt][r]);
            mx = fmaxf(mx, __shfl_xor(mx, 16)); mx = fmaxf(mx, __shfl_xor(mx, 32));
            float l = 0.f;
#pragma unroll
            for (int kt = 0; kt < 16; ++kt)
#pragma unroll
                for (int r = 0; r < 4; ++r) { const float pv = __builtin_amdgcn_exp2f((sc[kt][r] - mx) * SCL); sc[kt][r] = pv; l += pv; }
            l += __shfl_xor(l, 16); l += __shfl_xor(l, 32);
            const float rl = 1.f / l;
            f32x4 o[4];
#pragma unroll
            for (int dt = 0; dt < 4; ++dt) o[dt] = (f32x4){0.f, 0.f, 0.f, 0.f};
#pragma unroll
            for (int s = 0; s < 8; ++s) {
                const bf16x8 yp = pack8(sc[2 * s], sc[2 * s + 1]);
                bf16x8 xv[4];
#pragma unroll
                for (int dt = 0; dt < 4; ++dt) xv[dt] = ldsfrag(L + 32768 + swzV(16 * dt + fr, 4 * s + fq));
                SCB();
#pragma unroll
                for (int dt = 0; dt < 4; ++dt) o[dt] = mma(xv[dt], yp, o[dt]);
                SCB();
            }
#pragma unroll
            for (int dt = 0; dt < 4; ++dt) *(u32x2*)(mix + (size_t)(tok0 + fr) * D_ + 768 + hm * 64 + 16 * dt + 4 * fq) = pack4(o[dt] * rl);
        }
        __syncthreads();
    }
}

constexpr int AT_BUF = 40960, AT_KN = 0, AT_KR = 16384, AT_VT = 24576, AT_CTL = 2 * AT_BUF, AT_QR = 2 * AT_BUF + 1024;
__device__ __forceinline__ void mla_attn(ldsp L, const bf16_t* Qc, const bf16_t* Kc, const bf16_t* Vt, bf16_t* mix, unsigned* ctr, int tid, int wid, int lane) {
    const int fr = lane & 15, fq = lane >> 4;
    LAS int* ctl = (LAS int*)(L + AT_CTL);
    for (;;) {
        if (tid == 0) ctl[0] = (int)atomicAdd(ctr, 1u);
        __syncthreads();
        const int item = ctl[0];
        __syncthreads();
        if (item >= 384) break;
        const int qb = 63 - item / 6, h = item % 6;
        const int NT = 4 * qb + 4, q0 = 256 * qb + 32 * wid, tmax = 4 * qb + (wid >> 1);
        bf16x8 Q[2][4];
        const bf16_t* qrow = Qc + ((size_t)(q0 + fr) * 6 + h) * 192 + 8 * fq;
#pragma unroll
        for (int qs = 0; qs < 2; ++qs)
#pragma unroll
            for (int s = 0; s < 4; ++s) Q[qs][s] = gfrag(qrow + (size_t)qs * 16 * 1152 + 32 * s);
#pragma unroll
        for (int qs = 0; qs < 2; ++qs)
#pragma unroll
            for (int s = 0; s < 2; ++s) *(LAS bf16x8*)(L + AT_QR + wid * 4096 + (qs * 2 + s) * 1024 + lane * 16) = gfrag(qrow + (size_t)qs * 16 * 1152 + 128 + 32 * s);
        f32x4 O[2][8];
#pragma unroll
        for (int qs = 0; qs < 2; ++qs)
#pragma unroll
            for (int dt = 0; dt < 8; ++dt) O[qs][dt] = (f32x4){0.f, 0.f, 0.f, 0.f};
        float mrow[2] = {0.f, 0.f}, lrow[2] = {0.f, 0.f};
        const bf16_t* Kh = Kc + (size_t)h * S_ * 192; const bf16_t* Vh = Vt + (size_t)h * 128 * S_;
        const int rA = lane >> 4, cA = lane & 15, rB = lane >> 3, cB = lane & 7;
#define AT_DMA(t, buf) do { ldsp B_ = L + (buf) * AT_BUF; const size_t kb_ = (size_t)(t) * 64; \
        _Pragma("unroll") for (int i_ = 0; i_ < 2; ++i_) { const int pi_ = wid + 8 * i_, r_ = 4 * pi_ + rA; \
            __builtin_amdgcn_global_load_lds((const unsigned*)(Kh + (kb_ + r_) * 192 + ((cA ^ (r_ & 15)) << 3)), (LAS unsigned*)(B_ + AT_KN + pi_ * 1024), 16, 0, 0); } \
        { const int r_ = 8 * wid + rB; \
            __builtin_amdgcn_global_load_lds((const unsigned*)(Kh + (kb_ + r_) * 192 + 128 + ((cB ^ (r_ & 7)) << 3)), (LAS unsigned*)(B_ + AT_KR + wid * 1024), 16, 0, 0); } \
        _Pragma("unroll") for (int i_ = 0; i_ < 2; ++i_) { const int pi_ = wid + 8 * i_, r_ = 8 * pi_ + rB; \
            __builtin_amdgcn_global_load_lds((const unsigned*)(Vh + (size_t)r_ * S_ + kb_ + ((cB ^ (r_ & 7)) << 3)), (LAS unsigned*)(B_ + AT_VT + pi_ * 1024), 16, 0, 0); } } while (0)
        AT_DMA(0, 0);
        asm volatile("s_waitcnt vmcnt(0)" ::: "memory");
        __syncthreads();
        for (int t = 0; t < NT; ++t) {
            if (t + 1 < NT) AT_DMA(t + 1, (t + 1) & 1);
            if (t <= tmax) {
                ldsp B = L + (t & 1) * AT_BUF;
                f32x4 sc[2][4];
                bf16x8 Qr[2][2];
#pragma unroll
                for (int qs = 0; qs < 2; ++qs)
#pragma unroll
                    for (int s = 0; s < 2; ++s) Qr[qs][s] = ldsfrag(L + AT_QR + wid * 4096 + (qs * 2 + s) * 1024 + lane * 16);
                bf16x8 xa[6], v0[8];
#define AT_LDK(dst, kt) do { _Pragma("unroll") for (int s = 0; s < 4; ++s) dst[s] = ldsfrag(B + AT_KN + swzA(16 * (kt) + fr, 4 * s + fq)); \
                             dst[4] = ldsfrag(B + AT_KR + swzB(16 * (kt) + fr, fq)); dst[5] = ldsfrag(B + AT_KR + swzB(16 * (kt) + fr, 4 + fq)); } while (0)
#define AT_MMK(src, kt) do { sc[0][kt] = (f32x4){-mrow[0], -mrow[0], -mrow[0], -mrow[0]}; sc[1][kt] = (f32x4){-mrow[1], -mrow[1], -mrow[1], -mrow[1]}; \
                             _Pragma("unroll") for (int s = 0; s < 4; ++s) { sc[0][kt] = mma(src[s], Q[0][s], sc[0][kt]); sc[1][kt] = mma(src[s], Q[1][s], sc[1][kt]); } \
                             _Pragma("unroll") for (int s = 0; s < 2; ++s) { sc[0][kt] = mma(src[4 + s], Qr[0][s], sc[0][kt]); sc[1][kt] = mma(src[4 + s], Qr[1][s], sc[1][kt]); } } while (0)
#define AT_LDV(dst, d0) do { _Pragma("unroll") for (int q = 0; q < 4; ++q) { dst[2 * q] = ldsfrag(B + AT_VT + swzB(16 * ((d0) + q) + fr, fq)); dst[2 * q + 1] = ldsfrag(B + AT_VT + swzB(16 * ((d0) + q) + fr, 4 + fq)); } } while (0)
#define AT_MMV(src, d0) do { _Pragma("unroll") for (int q = 0; q < 4; ++q) { \
                             O[0][(d0) + q] = mma(src[2 * q], yp[0][0], O[0][(d0) + q]); O[1][(d0) + q] = mma(src[2 * q], yp[1][0], O[1][(d0) + q]); } \
                             _Pragma("unroll") for (int q = 0; q < 4; ++q) { \
                             O[0][(d0) + q] = mma(src[2 * q + 1], yp[0][1], O[0][(d0) + q]); O[1][(d0) + q] = mma(src[2 * q + 1], yp[1][1], O[1][(d0) + q]); } } while (0)
                AT_LDK(xa, 0); SCB(); AT_MMK(xa, 0); SCB();
                AT_LDK(xa, 1); SCB(); AT_MMK(xa, 1); SCB();
                AT_LDK(xa, 2); SCB(); AT_MMK(xa, 2); SCB();
                AT_LDK(xa, 3); SCB(); AT_MMK(xa, 3); SCB(); AT_LDV(v0, 0); SCB();
                bf16x8 yp[2][2];
#pragma unroll
                for (int qs = 0; qs < 2; ++qs) {
                    float mx = -1e30f;
#pragma unroll
                    for (int kt = 0; kt < 4; ++kt)
#pragma unroll
                        for (int r = 0; r < 4; ++r) mx = fmaxf(mx, sc[qs][kt][r]);
                    mx = fmaxf(mx, __shfl_xor(mx, 16)); mx = fmaxf(mx, __shfl_xor(mx, 32));
                    if (__any(t == 0 || mx > 8.f)) {
                        const float dl = t == 0 ? mx : fmaxf(mx, 0.f), alpha = __builtin_amdgcn_exp2f(-dl);
                        mrow[qs] += dl; lrow[qs] *= alpha;
#pragma unroll
                        for (int kt = 0; kt < 4; ++kt) sc[qs][kt] = sc[qs][kt] - dl;
#pragma unroll
                        for (int dt = 0; dt < 8; ++dt) O[qs][dt] = O[qs][dt] * alpha;
                    }
                    float ls = 0.f;
#pragma unroll
                    for (int kt = 0; kt < 4; ++kt)
#pragma unroll
                        for (int r = 0; r < 4; ++r) { const float pv = __builtin_amdgcn_exp2f(sc[qs][kt][r]); sc[qs][kt][r] = pv; ls += pv; }
                    lrow[qs] += ls;
                    yp[qs][0] = pack8(sc[qs][0], sc[qs][1]); yp[qs][1] = pack8(sc[qs][2], sc[qs][3]);
                }
                SCB(); AT_MMV(v0, 0); SCB(); AT_LDV(v0, 4); SCB(); AT_MMV(v0, 4); SCB();
#undef AT_LDK
#undef AT_MMK
#undef AT_LDV
#undef AT_MMV
            }
            asm volatile("s_waitcnt vmcnt(0)" ::: "memory");
            __syncthreads();
        }
#undef AT_DMA
#pragma unroll
        for (int qs = 0; qs < 2; ++qs) {
            float l = lrow[qs]; l += __shfl_xor(l, 16); l += __shfl_xor(l, 32);
            const float rl = 1.f / l;
#pragma unroll
            for (int dt = 0; dt < 8; ++dt) *(u32x2*)(mix + (size_t)(q0 + 16 * qs + fr) * D_ + h * 128 + 16 * dt + 4 * fq) = pack4(O[qs][dt] * rl);
        }
    }
}


#define XB_TMO      128
#define XB_XCNT(j)  (256  + 64 * (j))
#define XB_XSUB(j)  (1280 + 64 * (j))
#define XB_XGEN(j)  (2304 + 64 * (j))
#define XB_TOP      3328
#define XB_TOPGEN   3392
#define XCD_BAR_WORDS 3456
#define XB_SPIN_CAP (1u << 18)

__device__ __forceinline__ unsigned xb_ld(unsigned* p)              { return __hip_atomic_load(p, __ATOMIC_RELAXED, __HIP_MEMORY_SCOPE_AGENT); }
__device__ __forceinline__ unsigned xb_add(unsigned* p, unsigned v) { return __hip_atomic_fetch_add(p, v, __ATOMIC_RELAXED, __HIP_MEMORY_SCOPE_AGENT); }
__device__ __forceinline__ unsigned xb_xcc_id() { return (unsigned)__builtin_amdgcn_s_getreg((3 << 11) | 20) & 0xFu; }
#define XB_SPIN(cond, bar) do { unsigned _sp = 0; while (cond) { __builtin_amdgcn_s_sleep(1); \
    if ((++_sp & 255u) == 0u) { if (xb_ld(&(bar)[XB_TMO])) break; if (_sp > XB_SPIN_CAP) { atomicAdd(&(bar)[XB_TMO], 1u); break; } } } } while (0)

struct XcdBarrier {
    unsigned* bar; unsigned x;
    volatile LAS unsigned* st;
};

__device__ __forceinline__ XcdBarrier xcd_barrier_post(unsigned* bar, volatile LAS unsigned* st) {
    XcdBarrier b; b.bar = bar; b.x = xb_xcc_id(); b.st = st;
    if (threadIdx.x == 0) (void)xb_add(&bar[XB_XCNT(b.x)], 1u);
    return b;
}
__device__ __forceinline__ void xcd_barrier_complete(unsigned* bar, unsigned x, unsigned& nloc, unsigned& nx) {
    const unsigned G = gridDim.x * gridDim.y * gridDim.z;
    unsigned sum, cnt, mine, sp = 0u;
    for (;;) {
        sum = 0u; cnt = 0u; mine = 0u;
#pragma unroll
        for (unsigned j = 0; j < 16; ++j) { const unsigned c = xb_ld(&bar[XB_XCNT(j)]); sum += c; cnt += (c > 0u) ? 1u : 0u; mine = (j == x) ? c : mine; }
        if (sum == G) break;
        __builtin_amdgcn_s_sleep(1);
        if ((++sp & 255u) == 0u) { if (xb_ld(&bar[XB_TMO])) break; if (sp > XB_SPIN_CAP) { atomicAdd(&bar[XB_TMO], 1u); break; } }
    }
    nloc = mine > 0u ? mine : 1u; nx = cnt > 0u ? cnt : 1u;
}

__device__ __forceinline__ void xcd_barrier(const XcdBarrier& b) {
    asm volatile("s_waitcnt vmcnt(0)" ::: "memory");
    __syncthreads();
    if (threadIdx.x == 0) {
        unsigned* bar = b.bar;
        __builtin_amdgcn_s_waitcnt(0);
        unsigned nloc = b.st[0], nx = b.st[1];
        if (nloc == 0u) { xcd_barrier_complete(bar, b.x, nloc, nx); b.st[0] = nloc; b.st[1] = nx; }
        const unsigned old = xb_add(&bar[XB_XSUB(b.x)], 1u);
        const unsigned gen = old / nloc;
        if (old + 1u == (gen + 1u) * nloc) {
            __builtin_amdgcn_fence(__ATOMIC_RELEASE, "agent");
            asm volatile("s_waitcnt vmcnt(0)" ::: "memory");
            const unsigned og = xb_add(&bar[XB_TOP], 1u);
            const unsigned tg = og / nx;
            if (og + 1u == (tg + 1u) * nx) xb_add(&bar[XB_TOPGEN], 1u);
            else XB_SPIN(xb_ld(&bar[XB_TOPGEN]) == tg, bar);
            __builtin_amdgcn_fence(__ATOMIC_ACQUIRE, "agent");
            xb_add(&bar[XB_XGEN(b.x)], 1u);
            asm volatile("s_waitcnt vmcnt(0)" ::: "memory");
        } else {
            XB_SPIN(xb_ld(&bar[XB_XGEN(b.x)]) == gen, bar);
            __builtin_amdgcn_fence(__ATOMIC_ACQUIRE, "agent");
            asm volatile("s_waitcnt vmcnt(0)" ::: "memory");
        }
    }
    __syncthreads();
}

#ifndef RP_GU
#define RP_GU 1
#endif
#ifndef RP_INA
#define RP_INA 1
#endif
#ifndef RP_PREP
#define RP_PREP 1
#endif
#ifndef RP_SCAN
#define RP_SCAN 1
#endif
#ifndef RP_ATTN
#define RP_ATTN 1
#endif
#ifndef RP_MEM
#define RP_MEM 1
#endif
#ifndef RP_CONV
#define RP_CONV 1
#endif
#ifndef RP_UQ
#define RP_UQ 1
#endif
#ifndef RP_OUTROWS
#define RP_OUTROWS 1
#endif
#ifndef RP_P0
#define RP_P0 1
#endif
#ifndef REP_MEM
#define REP_MEM 1
#endif
#ifndef REP_ROWS
#define REP_ROWS 1
#endif
#ifndef REP_RES
#define REP_RES 1
#endif
#ifndef REP_INPROJ
#define REP_INPROJ 1
#endif
#ifndef REP_CONV
#define REP_CONV 1
#endif
#ifndef REP_GU
#define REP_GU 1
#endif
#ifndef REP_ATTN
#define REP_ATTN 1
#endif
#ifndef REP_SCAN
#define REP_SCAN 1
#endif
#ifndef REP_SYNC
#define REP_SYNC 1
#endif
#ifndef REP_PREP
#define REP_PREP 1
#endif
#define PHASE_IDS int tid_o_ = threadIdx.x; asm volatile("" : "+v"(tid_o_)); const int tid = tid_o_, lane = tid & 63, wid = __builtin_amdgcn_readfirstlane(tid >> 6), gw = bx * NW + wid; (void)lane; (void)gw; (void)tid
#define GSYNC_CG() do { asm volatile("s_waitcnt vmcnt(0) lgkmcnt(0)" ::: "memory"); grid.sync(); } while (0)
#define GSYNC() do { for (int r_ = 0; r_ < REP_SYNC; ++r_) xcd_barrier(xbar); } while (0)
#define CONV_UPPER(l_, grp_) do { if (2 * bx >= G) conv_group((const float* const*)(ws_ + WS_TAB), ws_, (l_), (grp_), L, (bx - G / 2) * NW + wid, (G - G / 2) * NW, lane, wid); __syncthreads();   } while (0)
#define SSQ(k) (WSP(float, WS_SSQ) + (size_t)(k) * S_ * 16)
#define WSP(T, off) ((T*)(ws_ + (off)))
#define INP(k) gptr(((const float* const*)(ws_ + WS_TAB)) + (k))
#define PHASE_BEGIN GAS unsigned char* wsg_ = (GAS unsigned char*)p.ws; int bx = blockIdx.x; asm volatile("" : "+s"(wsg_), "+s"(bx)); unsigned char* ws_ = (unsigned char*)wsg_; PHASE_IDS
__global__ void __launch_bounds__(NTHREADS, 2) fwd_megakernel(Params p) {
    extern __shared__ __attribute__((aligned(16))) unsigned char lds_raw[];
    cg::grid_group grid = cg::this_grid();
    ldsp L = (ldsp)lds_raw;
    const int G = gridDim.x, ngw = G * NW;
    volatile LAS unsigned* xst = (volatile LAS unsigned*)(L + XB_LDS_OFF);
    if (threadIdx.x < 2) xst[threadIdx.x] = 0u;
    __syncthreads();
    const XcdBarrier xbar = xcd_barrier_post((unsigned*)(p.ws + WS_XBAR), xst);

    {
        PHASE_BEGIN;
        if (tid == 0) {
            const float** T = (const float**)(ws_ + WS_TAB);
#pragma unroll
            for (int k = 0; k < 26; ++k) T[k] = p.in[k];
            float* TF = (float*)(ws_ + WS_TAB + 512);
#pragma unroll
            for (int k = 0; k < 32; ++k) TF[k] = p.invf[k];
        }
        asm volatile("s_waitcnt vmcnt(0)" ::: "memory");
        __syncthreads();
        __builtin_amdgcn_fence(__ATOMIC_ACQUIRE, "agent");
        const float* const* tin = (const float* const*)(ws_ + WS_TAB);
        LAS float* scr = (LAS float*)(L + wid * 16384);
        conv_group(tin, ws_, 0, 0, L, gw, ngw, lane, wid);
        conv_job(INP(22), D_, 320, 512, 0, WSP(bf16_t, WS_DKVT), scr, gw, ngw, lane, INP(21));
        conv_job(INP(24), 256, 1536, 768, 4, WSP(bf16_t, WS_UKT), scr, gw, ngw, lane);
        conv_job(INP(24), 256, 1536, 768, 5, WSP(bf16_t, WS_UVT), scr, gw, ngw, lane);
        norm_rows(INP(1), INP(11), WSP(bf16_t, WS_MEMN), 256, gw, ngw, lane);
        {
            const float* xin = INP(0); bf16_t* XB = WSP(bf16_t, WS_XN); float* sq0 = SSQ(12);
            for (int m = gw; m < S_; m += ngw) {
                float s = 0.f;
#pragma unroll
                for (int j = 0; j < 4; ++j) { const f32x4 v = *(const f32x4*)(xin + (size_t)m * D_ + 4 * lane + 256 * j);
                    u32x2 w; w.x = pk2(v[0], v[1]); w.y = pk2(v[2], v[3]); *(u32x2*)(XB + (size_t)m * D_ + 4 * lane + 256 * j) = w;
                    const float y0 = bflo(w.x), y1 = bfhi(w.x), y2 = bflo(w.y), y3 = bfhi(w.y); s += (y0 * y0 + y1 * y1) + (y2 * y2 + y3 * y3); }
                s = wave_sum(s);
                if (lane < 16) sq0[(size_t)m * 16 + lane] = lane == 0 ? s : 0.f;
            }
        }
        const int* positions = (const int*)INP(2);
        float2* ROPE = WSP(float2, WS_ROPE);
        for (int i = bx * NTHREADS + tid; i < S_ * 32; i += G * NTHREADS) {
            const int row = i >> 5, j = i & 31;
            const double a = (double)positions[row] * (double)((const float*)(ws_ + WS_TAB + 512))[j];
            const double rev = a * 0.15915494309189535; const float f = (float)(rev - rint(rev));
            ROPE[i] = make_float2(__builtin_amdgcn_cosf(f), __builtin_amdgcn_sinf(f));
        }
    }
    GSYNC_CG();

    for (int l = 0; l < 4; ++l) {
        const bool isA = l < 2;
        for (int rp_ = 0; rp_ < RP_GU; ++rp_) { PHASE_BEGIN; EpiSwiglu E{WSP(bf16_t, WS_H), l == 0 ? SSQ(12) : SSQ(3 * (l - 1) + 2)}; run_gemm(L, WSP(bf16_t, WS_XN), WSP(bf16_t, WS_W) + WO_GU1, S_, NGU, D_, bx, E); CONV_UPPER(l, 1); }
        {
            PHASE_BEGIN;
            EpiStore<true> Ek{WSP(bf16_t, WS_MEMK), 256, nullptr}; run_gemm(L, WSP(bf16_t, WS_MEMN), WSP(bf16_t, WS_W) + WO_MKV, 256, 256, D_, (bx + 1) % G, Ek);
            EpiStore<false> Ev{WSP(bf16_t, WS_MEMVT), 256, nullptr}; run_gemm(L, WSP(bf16_t, WS_W) + WO_MKV + (size_t)256 * D_, WSP(bf16_t, WS_MEMN), 256, 256, D_, (bx + 2) % G, Ev);
        }
        GSYNC();
        { PHASE_BEGIN; EpiResid E{WSP(bf16_t, WS_XN), 0.5f, SSQ(3 * l)}; run_gemm(L, WSP(bf16_t, WS_H), WSP(bf16_t, WS_W) + WO_D1, S_, D_, DFF, bx, E); }
        GSYNC();
        if (isA) {
            for (int rp_ = 0; rp_ < RP_INA; ++rp_) { PHASE_BEGIN; EpiStore<true> E{WSP(bf16_t, WS_HA), LDHA, SSQ(3 * l)}; run_gemm(L, WSP(bf16_t, WS_XN), WSP(bf16_t, WS_W) + WO_IN, S_, LDHA, D_, bx, E); CONV_UPPER(l, 2); }
            GSYNC();
            {
                PHASE_BEGIN;
                const float* convw = INP(14) + (size_t)l * 4 * 2304;
                for (int rp_ = 0; rp_ < RP_PREP; ++rp_) for (int u = bx; u < 1536; u += G) {
                    const int h = u % 6;
                    gdn_prep_unit(L, u, WSP(bf16_t, WS_HA), convw, __expf(INP(15)[l * 6 + h]), INP(16)[l * 6 + h],
                                  WSP(bf16_t, WS_NEGW), WSP(bf16_t, WS_QD), WSP(bf16_t, WS_KDT), WSP(bf16_t, WS_QK), WSP(bf16_t, WS_UT), WSP(float, WS_DCH), tid, wid, lane);
                }
            }
            for (int rp_ = 0; rp_ < RP_MEM; ++rp_) { PHASE_BEGIN; mem_attn(L, WSP(bf16_t, WS_HA), LDHA, QMA, WSP(bf16_t, WS_MEMK), WSP(bf16_t, WS_MEMVT), WSP(bf16_t, WS_MIX), tid, wid, lane); }
            GSYNC();
            for (int rp_ = 0; rp_ < RP_SCAN; ++rp_) if (blockIdx.x < 24) { PHASE_BEGIN; gdn_scan(L, bx >> 2, bx & 3, WSP(bf16_t, WS_NEGW), WSP(bf16_t, WS_QD), WSP(bf16_t, WS_KDT), WSP(bf16_t, WS_QK),
                                  WSP(bf16_t, WS_UT), WSP(float, WS_DCH), WSP(bf16_t, WS_HA), tid, wid, lane); }
            GSYNC();
            for (int rp_ = 0; rp_ < RP_OUTROWS; ++rp_) { PHASE_BEGIN; gdn_out_rows(WSP(bf16_t, WS_HA), INP(17) + l * 128, WSP(bf16_t, WS_MIX), gw, ngw, lane); }
            GSYNC();
        } else {
            { PHASE_BEGIN; EpiInB E{WSP(bf16_t, WS_HB), WSP(bf16_t, WS_CQN), SSQ(3 * l), WSP(float, WS_SQQ)}; run_gemm(L, WSP(bf16_t, WS_XN), WSP(bf16_t, WS_W) + WO_IN, S_, LDHB, D_, bx, E); CONV_UPPER(l, 2); }
            GSYNC();
            for (int rp_ = 0; rp_ < RP_UQ; ++rp_) { PHASE_BEGIN; EpiQ E{WSP(bf16_t, WS_QCAT), WSP(float2, WS_ROPE), 0.07216878364870323f * 1.4426950408889634f, WSP(float, WS_SQQ)}; run_gemm(L, WSP(bf16_t, WS_CQN), WSP(bf16_t, WS_W) + WO_UQ, S_, 1280, 256, bx, E); }
            GSYNC();
            for (int rp_ = 0; rp_ < RP_MEM; ++rp_) { PHASE_BEGIN; mem_attn(L, WSP(bf16_t, WS_HB), LDHB, QMB, WSP(bf16_t, WS_MEMK), WSP(bf16_t, WS_MEMVT), WSP(bf16_t, WS_MIX), tid, wid, lane); }
            for (int rp_ = 0; rp_ < RP_ATTN; ++rp_) { PHASE_BEGIN; mla_attn(L, WSP(bf16_t, WS_QCAT), WSP(bf16_t, WS_KCAT), WSP(bf16_t, WS_VT), WSP(bf16_t, WS_MIX), WSP(unsigned, WS_CTL) + 64 * (l - 2) + 128 * rp_, tid, wid, lane); __syncthreads(); }
            GSYNC();
        }
        { PHASE_BEGIN; EpiResid E{WSP(bf16_t, WS_XN), 1.0f, SSQ(3 * l + 1)}; run_gemm(L, WSP(bf16_t, WS_MIX), WSP(bf16_t, WS_W) + WO_OUT, S_, D_, D_, bx, E); }
        GSYNC();
        for (int rp_ = 0; rp_ < RP_GU; ++rp_) { PHASE_BEGIN; EpiSwiglu E{WSP(bf16_t, WS_H), SSQ(3 * l + 1)}; run_gemm(L, WSP(bf16_t, WS_XN), WSP(bf16_t, WS_W) + WO_GU2, S_, NGU, D_, bx, E); if (l < 3) CONV_UPPER(l + 1, 0); }
        GSYNC();
        { PHASE_BEGIN; EpiResid E{WSP(bf16_t, WS_XN), 0.5f, SSQ(3 * l + 2)}; run_gemm(L, WSP(bf16_t, WS_H), WSP(bf16_t, WS_W) + WO_D2, S_, D_, DFF, bx, E); }
        GSYNC();
        if (l == 1) {
            { PHASE_BEGIN; EpiStore<true> E{WSP(bf16_t, WS_HB), 512, SSQ(5)}; run_gemm(L, WSP(bf16_t, WS_XN), WSP(bf16_t, WS_DKVT), S_, 512, D_, bx, E); }
            GSYNC();
            {
                PHASE_BEGIN;
                const bf16_t* CKR = WSP(bf16_t, WS_HB); bf16_t* CKVN = WSP(bf16_t, WS_CQN); bf16_t* KCAT = WSP(bf16_t, WS_KCAT); const float2* ROPE = WSP(float2, WS_ROPE);
                const f32x4 gg = *(const f32x4*)(INP(23) + 4 * lane);
                for (int m = gw; m < S_; m += ngw) {
                    const bf16_t* rp = CKR + (size_t)m * 512;
                    const u32x2 v = *(const u32x2*)(rp + 4 * lane);
                    const float a0 = bflo(v.x), a1 = bfhi(v.x), a2 = bflo(v.y), a3 = bfhi(v.y);
                    const float r = rsqrtf(wave_sum(a0 * a0 + a1 * a1 + a2 * a2 + a3 * a3) * (1.f / 256.f) + EPS);
                    u32x2 w; w.x = pk2(a0 * r * gg[0], a1 * r * gg[1]); w.y = pk2(a2 * r * gg[2], a3 * r * gg[3]);
                    *(u32x2*)(CKVN + (size_t)m * 256 + 4 * lane) = w;
                    if (lane < 32) {
                        const float x1 = bf2f(rp[256 + lane]), x2 = bf2f(rp[288 + lane]);
                        const float2 cs = ROPE[(size_t)m * 32 + lane];
                        const unsigned o = pk2(x1 * cs.x - x2 * cs.y, x1 * cs.y + x2 * cs.x);
#pragma unroll
                        for (int h = 0; h < 6; ++h) { bf16_t* kp = KCAT + ((size_t)h * S_ + m) * 192 + 128 + lane; kp[0] = (bf16_t)(o & 0xffffu); kp[32] = (bf16_t)(o >> 16); }
                    }
                }
            }
            GSYNC();
            { PHASE_BEGIN; EpiKnope E{WSP(bf16_t, WS_KCAT)}; run_gemm(L, WSP(bf16_t, WS_CQN), WSP(bf16_t, WS_UKT), S_, 768, 256, bx, E); }
            { PHASE_BEGIN; EpiStore<false> E{WSP(bf16_t, WS_VT), S_, nullptr}; run_gemm(L, WSP(bf16_t, WS_UVT), WSP(bf16_t, WS_CQN), 768, S_, 256, bx, E); }
            GSYNC();
        }
    }
    {
        PHASE_BEGIN;
        const float* g = INP(25); const bf16_t* XB = WSP(bf16_t, WS_XN);
        for (int m = gw; m < S_; m += ngw) {
            float* orow = p.out + (size_t)m * D_;
            f32x4 v[4]; float s = 0.f;
#pragma unroll
            for (int j = 0; j < 4; ++j) { const u32x2 w = *(const u32x2*)(XB + (size_t)m * D_ + 4 * lane + 256 * j);
                v[j] = (f32x4){bflo(w.x), bfhi(w.x), bflo(w.y), bfhi(w.y)}; s += (v[j][0] * v[j][0] + v[j][1] * v[j][1]) + (v[j][2] * v[j][2] + v[j][3] * v[j][3]); }
            const float r = rsqrtf(wave_sum(s) * (1.f / D_) + EPS);
#pragma unroll
            for (int j = 0; j < 4; ++j) { const f32x4 gg = *(const f32x4*)(g + 4 * lane + 256 * j); *(f32x4*)(orow + 4 * lane + 256 * j) = v[j] * r * gg; }
        }
    }
}

extern "C" void kernel_launch(void* const* d_in, const int* in_sizes, int n_in, void* d_out, int out_size, void* d_ws, size_t ws_size, hipStream_t stream) {
    static int grid_blocks = 0;
    if (grid_blocks == 0) {
        int dev = 0, cus = 0, per_cu = 0;
        hipGetDevice(&dev);
        hipDeviceGetAttribute(&cus, hipDeviceAttributeMultiprocessorCount, dev);
        hipFuncSetAttribute((const void*)fwd_megakernel, hipFuncAttributeMaxDynamicSharedMemorySize, LDS_BYTES);
        hipOccupancyMaxActiveBlocksPerMultiprocessor(&per_cu, (const void*)fwd_megakernel, NTHREADS, LDS_BYTES);
        if (per_cu < 1) per_cu = 1;
        grid_blocks = cus * per_cu;
        if (ws_size < WS_END) fprintf(stderr, "kernel_launch: workspace too small: %zu < %zu\n", ws_size, (size_t)WS_END);
    }
    (void)hipMemsetAsync((char*)d_ws + WS_CTL, 0, CTL_ZERO_BYTES, stream);
    Params p{};
    for (int i = 0; i < 26; ++i) p.in[i] = (const float*)d_in[i];
    p.out = (float*)d_out; p.ws = (unsigned char*)d_ws;
    for (int j = 0; j < 32; ++j) p.invf[j] = (float)pow(10000.0, -(double)(2 * j) / 64.0);
    void* args[] = {&p};
    hipError_t e = hipLaunchCooperativeKernel((const void*)fwd_megakernel, dim3(grid_blocks), dim3(NTHREADS), args, LDS_BYTES, stream);
    if (e != hipSuccess) fprintf(stderr, "cooperative launch failed: %s (grid %d)\n", hipGetErrorString(e), grid_blocks);
}
```

```cpp
#include <hip/hip_runtime.h>
#include <hip/hip_cooperative_groups.h>
#include <cstdio>
#include <cstdint>
#include <cmath>
namespace cg = cooperative_groups;
namespace pg8 {
#define PG8_LAS __attribute__((address_space(3)))
typedef unsigned short bf16_t;
typedef short bf16x8 __attribute__((ext_vector_type(8)));
typedef float f32x4 __attribute__((ext_vector_type(4)));
typedef unsigned u32x4 __attribute__((ext_vector_type(4)));
constexpr int BM = 256, BK = 64, HALF = 128, HTB = HALF * BK * 2  , STAGE_BYTES = 8 * HTB, NXCD = 8, WGM = 4;

__host__ __device__ __forceinline__ int lds_byte(int r, int c) { const int st = (r >> 4) * 2 + (c >> 5), rr = r & 15, cc = c & 31, ob = rr * 64 + cc * 2; return st * 1024 + (ob ^ (((ob >> 9) & 1) << 5)); }
__host__ __device__ __forceinline__ void stage_rc(int b, int& R, int& C) { const int st = b / 1024, sb = b % 1024, swz = sb ^ (((sb >> 9) & 1) << 5); R = (st >> 1) * 16 + swz / 64; C = (st & 1) * 32 + (swz % 64) / 2; }
__host__ __device__ __forceinline__ int perm32(int rho) { const int n = rho >> 4, i = rho & 15; return 8 * (i >> 2) + 4 * n + (i & 3); }

struct Unit { int pm, pn; };
struct Gemm { const bf16_t* A; const bf16_t* Bt; int M, N, K; };

struct StaticOrder {
    int nM, nN, nwg, G, c;
    __host__ __device__ void init(int M, int N, int G_, int c_) { nM = M / BM; nN = N / BM; nwg = nM * nN; G = G_; c = c_; }
    __host__ __device__ bool next(int i, Unit& u) const {
        const long L = (long)i * G + c; if (L >= nwg) return false;
        int wgid = (int)L; { const int q = nwg / NXCD, r = nwg % NXCD, xcd = wgid % NXCD, off = wgid / NXCD; wgid = (xcd < r ? xcd * (q + 1) : r * (q + 1) + (xcd - r) * q) + off; }
        const int nig = WGM * nN, gid = wgid / nig, fm = gid * WGM, gsz = (nM - fm) < WGM ? (nM - fm) : WGM;
        u.pm = fm + ((wgid % nig) % gsz); u.pn = (wgid % nig) / gsz; return true;
    }
    __device__ __forceinline__ void a_ready(const Unit&) const {}
    __device__ __forceinline__ void done(const Unit&) const {}
};

__device__ __forceinline__ unsigned cvt_pk_bf16(float lo, float hi) { unsigned r; asm volatile("v_cvt_pk_bf16_f32 %0, %1, %2" : "=v"(r) : "v"(lo), "v"(hi)); return r; }
typedef float f32x2 __attribute__((ext_vector_type(2)));
template <class Epi, class Sched, bool ALIGN_EPI = false, bool SP2 = false>
__device__ __forceinline__ void gemm_phase(PG8_LAS unsigned char* lds, const Gemm g, const Sched& S, const Epi& E) {
    int tid_o = threadIdx.x; asm volatile("" : "+v"(tid_o)); const int tid = tid_o, wid = __builtin_amdgcn_readfirstlane(tid >> 6), lane = tid & 63, wr = wid >> 2, wc = wid & 3, fr = lane & 15, fq = lane >> 4;
    const int K = g.K, nt = K / BK;
    unsigned voffA[2], voffB[2];
#pragma unroll
    for (int i = 0; i < 2; ++i) { int R, C; stage_rc(tid * 16 + i * 8192, R, C); const int Rb = Epi::PERM ? ((R & ~31) + perm32(R & 31)) : R;
        voffA[i] = (unsigned)(R * K + C) * 2u; voffB[i] = (unsigned)(Rb * K + C) * 2u; }
    const size_t kstep = (size_t)(BK * 2);
    const size_t hstep = (size_t)HALF * K * 2;
    const size_t tstep = 2 * hstep;
    const unsigned ldsw = (unsigned)wid * 1024u;
    const int aoff = lds_byte(wr * 64 + fr, fq * 8), boff = lds_byte(wc * 32 + fr, fq * 8);
#define PG8_SA(b, h) (((b) * 2 + (h)) * HTB)
#define PG8_SB(b, h) ((4 + (b) * 2 + (h)) * HTB)
#define PG8_STAGE(bufoff, gbase, voff) do { _Pragma("unroll") for (int _i = 0; _i < 2; ++_i) \
        __builtin_amdgcn_global_load_lds((const unsigned*)((const char*)(gbase) + (voff)[_i]), (PG8_LAS unsigned*)(lds + (bufoff) + ldsw + _i * 8192), 16, 0, 0); } while (0)
#define PG8_LDA(dst, b, h) do { _Pragma("unroll") for (int m = 0; m < 4; ++m) _Pragma("unroll") for (int k = 0; k < 2; ++k) dst[m][k] = *(const PG8_LAS bf16x8*)(lds + PG8_SA(b, h) + aoff + m * 2048 + k * 1024); } while (0)
#define PG8_LDB(dst, b, h) do { _Pragma("unroll") for (int n = 0; n < 2; ++n) _Pragma("unroll") for (int k = 0; k < 2; ++k) dst[n][k] = *(const PG8_LAS bf16x8*)(lds + PG8_SB(b, h) + boff + n * 2048 + k * 1024); } while (0)
#define PG8_MMA(ai, bj, At, Bt) do { __builtin_amdgcn_s_setprio(1); _Pragma("unroll") for (int m = 0; m < 4; ++m) _Pragma("unroll") for (int n = 0; n < 2; ++n) _Pragma("unroll") for (int k = 0; k < 2; ++k) \
        acc[ai][bj][m][n] = __builtin_amdgcn_mfma_f32_16x16x32_bf16(Bt[n][k], At[m][k], acc[ai][bj][m][n], 0, 0, 0); __builtin_amdgcn_s_setprio(0); } while (0)
#define PG8_WAIT_V(n) asm volatile("s_waitcnt vmcnt(" #n ")" ::: "memory")
#define PG8_WAIT_L(n) asm volatile("s_waitcnt lgkmcnt(" #n ")" ::: "memory")
#define PG8_BAR __builtin_amdgcn_s_barrier()
#define PG8_SCHED __builtin_amdgcn_sched_barrier(0)
    Unit cur, nxt; int ui = 0;
    if (!S.next(0, cur)) return;
    f32x4 acc[2][2][4][2];
#pragma unroll
    for (int a = 0; a < 2; ++a)
#pragma unroll
        for (int b = 0; b < 2; ++b)
#pragma unroll
            for (int m = 0; m < 4; ++m)
#pragma unroll
                for (int n = 0; n < 2; ++n) acc[a][b][m][n] = (f32x4){0.f, 0.f, 0.f, 0.f};
    bf16x8 At[4][2], B0[2][2], B1[2][2];
    const char* cA = (const char*)g.A + (size_t)cur.pm * tstep; const char* cB = (const char*)g.Bt + (size_t)cur.pn * tstep;
    S.a_ready(cur);
    if constexpr (SP2) {
        PG8_STAGE(PG8_SB(0, 0), cB, voffB); PG8_STAGE(PG8_SB(0, 1), cB + hstep, voffB); PG8_STAGE(PG8_SA(0, 0), cA, voffA); PG8_STAGE(PG8_SA(0, 1), cA + hstep, voffA);
        if (wr == 1) PG8_BAR;
        PG8_WAIT_V(2); PG8_BAR;
        PG8_STAGE(PG8_SB(1, 0), cB + kstep, voffB); PG8_STAGE(PG8_SA(1, 0), cA + kstep, voffA); PG8_STAGE(PG8_SB(1, 1), cB + hstep + kstep, voffB);
        PG8_WAIT_V(6); PG8_BAR;
    } else {
        PG8_STAGE(PG8_SB(0, 0), cB, voffB); PG8_STAGE(PG8_SA(0, 0), cA, voffA); PG8_STAGE(PG8_SB(0, 1), cB + hstep, voffB); PG8_STAGE(PG8_SA(0, 1), cA + hstep, voffA);
        if (wr == 1) PG8_BAR;
        PG8_WAIT_V(4); PG8_BAR;
        PG8_STAGE(PG8_SB(1, 0), cB + kstep, voffB); PG8_STAGE(PG8_SA(1, 0), cA + kstep, voffA); PG8_STAGE(PG8_SB(1, 1), cB + hstep + kstep, voffB);
        PG8_WAIT_V(6); PG8_BAR;
    }
    for (;;) {
        const bool has_next = S.next(ui + 1, nxt);
        const char* nA = has_next ? (const char*)g.A + (size_t)nxt.pm * tstep : cA; const char* nB = has_next ? (const char*)g.Bt + (size_t)nxt.pn * tstep : cB;
        for (int t = 0; t < nt; t += 2) {
            const bool last = (t == nt - 2);
            const char* a1 = cA + (size_t)(t + 1) * kstep;
            const char* a2 = last ? nA : cA + (size_t)(t + 2) * kstep; const char* b2 = last ? nB : cB + (size_t)(t + 2) * kstep;
            const char* a3 = a2 + kstep; const char* b3 = b2 + kstep;
            if (last && has_next) S.a_ready(nxt);
            if constexpr (SP2) {
            PG8_LDB(B0, 0, 0); PG8_LDB(B1, 0, 1); PG8_SCHED; PG8_LDA(At, 0, 0); PG8_STAGE(PG8_SA(1, 1), a1 + hstep, voffA);
            PG8_WAIT_V(8); PG8_WAIT_L(0); PG8_BAR; PG8_MMA(0, 0, At, B0); PG8_MMA(0, 1, At, B1); PG8_BAR; PG8_SCHED;
            PG8_LDA(At, 0, 1); PG8_STAGE(PG8_SB(0, 0), b2, voffB); PG8_STAGE(PG8_SB(0, 1), b2 + hstep, voffB); PG8_STAGE(PG8_SA(0, 0), a2, voffA);
            PG8_WAIT_V(8); PG8_WAIT_L(0); PG8_BAR; PG8_MMA(1, 0, At, B0); PG8_MMA(1, 1, At, B1); PG8_BAR; PG8_SCHED;
            PG8_LDB(B0, 1, 0); PG8_LDB(B1, 1, 1); PG8_SCHED; PG8_LDA(At, 1, 0); PG8_STAGE(PG8_SA(0, 1), a2 + hstep, voffA);
            PG8_WAIT_V(8); PG8_WAIT_L(0); PG8_BAR; PG8_MMA(0, 0, At, B0); PG8_MMA(0, 1, At, B1); PG8_BAR; PG8_SCHED;
            PG8_LDA(At, 1, 1); PG8_STAGE(PG8_SB(1, 0), b3, voffB); PG8_STAGE(PG8_SB(1, 1), b3 + hstep, voffB); PG8_STAGE(PG8_SA(1, 0), a3, voffA);
            PG8_WAIT_V(8); PG8_WAIT_L(0); PG8_BAR; PG8_MMA(1, 0, At, B0); PG8_MMA(1, 1, At, B1); PG8_BAR; PG8_SCHED;
            } else {
            PG8_LDB(B0, 0, 0); PG8_SCHED; PG8_LDA(At, 0, 0); PG8_STAGE(PG8_SA(1, 1), a1 + hstep, voffA);
            PG8_WAIT_L(8); PG8_BAR; PG8_WAIT_L(0); PG8_MMA(0, 0, At, B0); PG8_BAR; PG8_SCHED;
            PG8_LDB(B1, 0, 1); PG8_STAGE(PG8_SB(0, 0), b2, voffB);
            PG8_BAR; PG8_WAIT_L(0); PG8_MMA(0, 1, At, B1); PG8_BAR;
            PG8_LDA(At, 0, 1); PG8_STAGE(PG8_SA(0, 0), a2, voffA);
            PG8_BAR; PG8_WAIT_L(0); PG8_MMA(1, 0, At, B0); PG8_BAR; PG8_SCHED;
            PG8_STAGE(PG8_SB(0, 1), b2 + hstep, voffB);
            PG8_WAIT_V(6); PG8_BAR; PG8_MMA(1, 1, At, B1); PG8_BAR;
            PG8_LDB(B0, 1, 0); PG8_SCHED; PG8_LDA(At, 1, 0); PG8_STAGE(PG8_SA(0, 1), a2 + hstep, voffA);
            PG8_WAIT_L(8); PG8_BAR; PG8_WAIT_L(0); PG8_MMA(0, 0, At, B0); PG8_BAR; PG8_SCHED;
            PG8_LDB(B1, 1, 1); PG8_STAGE(PG8_SB(1, 0), b3, voffB);
            PG8_BAR; PG8_WAIT_L(0); PG8_MMA(0, 1, At, B1); PG8_BAR;
            PG8_LDA(At, 1, 1); PG8_STAGE(PG8_SA(1, 0), a3, voffA);
            PG8_BAR; PG8_WAIT_L(0); PG8_MMA(1, 0, At, B0); PG8_BAR; PG8_SCHED;
            PG8_STAGE(PG8_SB(1, 1), b3 + hstep, voffB);
            PG8_WAIT_V(6); PG8_BAR; PG8_MMA(1, 1, At, B1); PG8_BAR;
            }
        }
        if constexpr (ALIGN_EPI) { if (wr == 0) PG8_BAR; }
        if constexpr (!Epi::AFTER_DRAIN) { E(acc, cur, wr, wc, fr, fq); S.done(cur); }
        if (!has_next) break;
#pragma unroll
        for (int a = 0; a < 2; ++a)
#pragma unroll
            for (int b = 0; b < 2; ++b)
#pragma unroll
                for (int m = 0; m < 4; ++m)
#pragma unroll
                    for (int n = 0; n < 2; ++n) acc[a][b][m][n] = (f32x4){0.f, 0.f, 0.f, 0.f};
        cur = nxt; cA = nA; cB = nB; ++ui;
        if constexpr (ALIGN_EPI) { if (wr == 1) PG8_BAR; }
    }
    PG8_WAIT_V(0);
    if constexpr (!ALIGN_EPI) { if (wr == 0) PG8_BAR; }
    PG8_BAR;
    if constexpr (Epi::AFTER_DRAIN) { E.fused(acc, cur, wr, wc, fr, fq, lds, wid, lane); S.done(cur); }
#undef PG8_SA
#undef PG8_SB
#undef PG8_STAGE
#undef PG8_LDA
#undef PG8_LDB
#undef PG8_MMA
#undef PG8_WAIT_V
#undef PG8_WAIT_L
#undef PG8_BAR
#undef PG8_SCHED
}
}

#define LAS __attribute__((address_space(3)))
using pg8::bf16_t; using pg8::bf16x8; using pg8::f32x4; using pg8::u32x4;
typedef unsigned u32x2 __attribute__((ext_vector_type(2)));
typedef LAS unsigned char* ldsp;

constexpr int S_ = 16384, D_ = 1024, DFF = 2816, NGU = 5632;
constexpr int LDHA = 3584, QMA = 3328, LDHB = 512, QMB = 256;
constexpr int NTHREADS = 512, NW = 8;
constexpr int LDS_BYTES = 147456, XB_LDS_OFF = 147200;
constexpr float EPS = 1e-6f;

constexpr size_t MiB = 1u << 20;
constexpr size_t WS_CTL = 0, WS_TAB = 2048, WS_XBAR = 16384, CTL_ZERO_BYTES = 32768, WS_ROPE = 1 * MiB, WS_MEMN = 5 * MiB, WS_MEMK = 5 * MiB + 512 * 1024, WS_MEMVT = 5 * MiB + 640 * 1024;
constexpr size_t WS_DKVT = 6 * MiB, WS_UKT = 7 * MiB, WS_UVT = 7 * MiB + 384 * 1024;
constexpr size_t WS_W = 8 * MiB, WS_X = 54 * MiB, WS_XN = 118 * MiB, WS_KCAT = 150 * MiB, WS_VT = 186 * MiB;
constexpr size_t WS_HA = 150 * MiB, WS_NEGW = 262 * MiB, WS_QD = 286 * MiB, WS_KDT = 310 * MiB, WS_QK = 334 * MiB, WS_UT = 346 * MiB, WS_DCH = 370 * MiB;
constexpr size_t WS_H = 210 * MiB, WS_HB = 210 * MiB, WS_CQN = 226 * MiB, WS_QCAT = 234 * MiB;
constexpr size_t WS_MIX = 54 * MiB;
constexpr size_t WS_XG2 = 298 * MiB;
constexpr size_t WS_SSQ = 371 * MiB;
constexpr size_t WS_SQQ = 384 * MiB;
constexpr size_t WS_END = 385 * MiB;
constexpr size_t WO_GU1 = 0, WO_D1 = 5767168, WO_GU2 = 8650752, WO_D2 = 14417920, WO_OUT = 17301504, WO_MKV = 18350080, WO_IN = 18874368, WO_UQ = 19398656;

#define GAS __attribute__((address_space(1)))
__device__ __forceinline__ const float* gptr(const float* const* slot) { const unsigned long long v = *(const unsigned long long*)slot; return (const float*)(GAS const float*)v; }
struct Params { const float* in[26]; float* out; unsigned char* ws; float invf[32]; };

typedef float f32x2_t __attribute__((ext_vector_type(2))); typedef __bf16 bf16x2_t __attribute__((ext_vector_type(2)));
__device__ __forceinline__ unsigned pk2(float lo, float hi) { f32x2_t v = {lo, hi}; bf16x2_t b = __builtin_convertvector(v, bf16x2_t); return __builtin_bit_cast(unsigned, b); }
__device__ __forceinline__ float bf2f(unsigned short b) { return __uint_as_float(((unsigned)b) << 16); }
__device__ __forceinline__ float bflo(unsigned w) { return __uint_as_float(w << 16); }
__device__ __forceinline__ float bfhi(unsigned w) { return __uint_as_float(w & 0xffff0000u); }
__device__ __forceinline__ float wave_sum(float v) {
#pragma unroll
    for (int o = 1; o < 64; o <<= 1) v += __shfl_xor(v, o);
    return v;
}
__device__ __forceinline__ f32x4 mma(bf16x8 x, bf16x8 y, f32x4 c) { return __builtin_amdgcn_mfma_f32_16x16x32_bf16(x, y, c, 0, 0, 0); }
__device__ __forceinline__ float silu_f(float v) { return v * __builtin_amdgcn_rcpf(1.f + __builtin_amdgcn_exp2f(v * -1.4426950408889634f)); }
__device__ __forceinline__ int swzA(int r, int ch) { return r * 256 + ((ch ^ (r & 15)) << 4); }
__device__ __forceinline__ int swzB(int r, int ch) { return r * 128 + ((ch ^ (r & 7)) << 4); }
__device__ __forceinline__ bf16x8 ldsfrag(ldsp p) { return *(LAS bf16x8*)p; }
__device__ __forceinline__ bf16x8 gfrag(const bf16_t* p) { return *(const bf16x8*)p; }
__device__ __forceinline__ bf16x8 pack8(f32x4 a, f32x4 b) { u32x4 w; w.x = pk2(a[0], a[1]); w.y = pk2(a[2], a[3]); w.z = pk2(b[0], b[1]); w.w = pk2(b[2], b[3]); return __builtin_bit_cast(bf16x8, w); }
__device__ __forceinline__ u32x2 pack4(f32x4 a) { u32x2 w; w.x = pk2(a[0], a[1]); w.y = pk2(a[2], a[3]); return w; }

__device__ __forceinline__ float row_rstd(const float* ssq, int row, int fq) {
    const f32x4 pv = *(const f32x4*)(ssq + (size_t)row * 16 + 4 * fq);
    float s = (pv[0] + pv[1]) + (pv[2] + pv[3]);
    s += __shfl_xor(s, 16); s += __shfl_xor(s, 32);
    return rsqrtf(s * (1.f / D_) + EPS);
}
__device__ __forceinline__ void row_rstd8(const float* ssq, int row0, int fq, float (&r8)[2][4]) {
    f32x4 pv[2][4];
#pragma unroll
    for (int ai = 0; ai < 2; ++ai)
#pragma unroll
        for (int m = 0; m < 4; ++m) pv[ai][m] = *(const f32x4*)(ssq + (size_t)(row0 + ai * 128 + m * 16) * 16 + 4 * fq);
#pragma unroll
    for (int ai = 0; ai < 2; ++ai)
#pragma unroll
        for (int m = 0; m < 4; ++m) { float s = (pv[ai][m][0] + pv[ai][m][1]) + (pv[ai][m][2] + pv[ai][m][3]);
            s += __shfl_xor(s, 16); s += __shfl_xor(s, 32); r8[ai][m] = rsqrtf(s * (1.f / D_) + EPS); }
}
struct EpiSwiglu {
    static constexpr bool PERM = true, AFTER_DRAIN = false; bf16_t* H; const float* ssq;
    __device__ __forceinline__ void operator()(const f32x4 (&acc)[2][2][4][2], const pg8::Unit& u, int wr, int wc, int fr, int fq) const {
        const int row0 = u.pm * 256 + wr * 64 + fr, col = u.pn * 128 + wc * 32 + 8 * fq;
        float r8[2][4]; row_rstd8(ssq, row0, fq, r8);
#pragma unroll
        for (int ai = 0; ai < 2; ++ai)
#pragma unroll
            for (int m = 0; m < 4; ++m) {
                const float r = r8[ai][m];
                const f32x4 g0 = acc[ai][0][m][0] * r, g1 = acc[ai][0][m][1] * r, u0 = acc[ai][1][m][0] * r, u1 = acc[ai][1][m][1] * r;
                u32x4 w;
                w.x = pk2(silu_f(g0[0]) * u0[0], silu_f(g0[1]) * u0[1]); w.y = pk2(silu_f(g0[2]) * u0[2], silu_f(g0[3]) * u0[3]);
                w.z = pk2(silu_f(g1[0]) * u1[0], silu_f(g1[1]) * u1[1]); w.w = pk2(silu_f(g1[2]) * u1[2], silu_f(g1[3]) * u1[3]);
                *(u32x4*)(H + (size_t)(row0 + ai * 128 + m * 16) * DFF + col) = w;
            }
    }
};
struct EpiResid {
    static constexpr bool PERM = false, AFTER_DRAIN = false; bf16_t* xb; float scale; float* ssq;
    __device__ __forceinline__ void operator()(const f32x4 (&acc)[2][2][4][2], const pg8::Unit& u, int wr, int wc, int fr, int fq) const {
        const int row0 = u.pm * 256 + wr * 64 + fr, col0 = u.pn * 256 + wc * 32 + 4 * fq;
#pragma unroll
        for (int ai = 0; ai < 2; ++ai)
#pragma unroll
            for (int m = 0; m < 4; ++m) {
                const int row = row0 + ai * 128 + m * 16;
                float sq = 0.f;
#pragma unroll
                for (int bj = 0; bj < 2; ++bj)
#pragma unroll
                    for (int n = 0; n < 2; ++n) {
                        const size_t off = (size_t)row * D_ + col0 + bj * 128 + n * 16;
                        const u32x2 b = *(const u32x2*)(xb + off);
                        const f32x4 a = acc[ai][bj][m][n];
                        u32x2 w; w.x = pk2(bflo(b.x) + a[0] * scale, bfhi(b.x) + a[1] * scale); w.y = pk2(bflo(b.y) + a[2] * scale, bfhi(b.y) + a[3] * scale);
                        *(u32x2*)(xb + off) = w;
                        const float y0 = bflo(w.x), y1 = bfhi(w.x), y2 = bflo(w.y), y3 = bfhi(w.y);
                        sq += (y0 * y0 + y1 * y1) + (y2 * y2 + y3 * y3);
                    }
                sq += __shfl_xor(sq, 16); sq += __shfl_xor(sq, 32);
                if (fq == 0) ssq[(size_t)row * 16 + u.pn * 4 + wc] = sq;
            }
    }
};
template <bool P> struct EpiStore {
    static constexpr bool PERM = P, AFTER_DRAIN = false; bf16_t* O; int ldc; const float* ssq;
    __device__ __forceinline__ void operator()(const f32x4 (&acc)[2][2][4][2], const pg8::Unit& u, int wr, int wc, int fr, int fq) const {
        const int row0 = u.pm * 256 + wr * 64 + fr, col0 = u.pn * 256 + wc * 32 + 8 * fq;
        float r8[2][4];
        if (ssq) row_rstd8(ssq, row0, fq, r8);
#pragma unroll
        for (int ai = 0; ai < 2; ++ai)
#pragma unroll
            for (int m = 0; m < 4; ++m) {
                const float r = ssq ? r8[ai][m] : 1.f;
#pragma unroll
                for (int bj = 0; bj < 2; ++bj) {
                    u32x4 w; const f32x4 a = acc[ai][bj][m][0] * r, b = acc[ai][bj][m][1] * r;
                    w.x = pk2(a[0], a[1]); w.y = pk2(a[2], a[3]); w.z = pk2(b[0], b[1]); w.w = pk2(b[2], b[3]);
                    *(u32x4*)(O + (size_t)(row0 + ai * 128 + m * 16) * ldc + col0 + bj * 128) = w;
                }
            }
    }
};
struct EpiInB {
    static constexpr bool PERM = true, AFTER_DRAIN = false; bf16_t* HB; bf16_t* CQ; const float* ssq; float* sqq;
    __device__ __forceinline__ void operator()(const f32x4 (&acc)[2][2][4][2], const pg8::Unit& u, int wr, int wc, int fr, int fq) const {
        const int row0 = u.pm * 256 + wr * 64 + fr, cw = wc * 32 + 8 * fq;
        float r8[2][4]; row_rstd8(ssq, row0, fq, r8);
#pragma unroll
        for (int ai = 0; ai < 2; ++ai)
#pragma unroll
            for (int m = 0; m < 4; ++m) {
                const int row = row0 + ai * 128 + m * 16;
                const float r = r8[ai][m];
                float sq = 0.f;
#pragma unroll
                for (int bj = 0; bj < 2; ++bj) {
                    u32x4 w; const f32x4 a = acc[ai][bj][m][0] * r, b = acc[ai][bj][m][1] * r;
                    w.x = pk2(a[0], a[1]); w.y = pk2(a[2], a[3]); w.z = pk2(b[0], b[1]); w.w = pk2(b[2], b[3]);
                    if (u.pn == 0) {
                        *(u32x4*)(CQ + (size_t)row * 256 + bj * 128 + cw) = w;
                        const float y0 = bflo(w.x), y1 = bfhi(w.x), y2 = bflo(w.y), y3 = bfhi(w.y), y4 = bflo(w.z), y5 = bfhi(w.z), y6 = bflo(w.w), y7 = bfhi(w.w);
                        sq += ((y0 * y0 + y1 * y1) + (y2 * y2 + y3 * y3)) + ((y4 * y4 + y5 * y5) + (y6 * y6 + y7 * y7));
                    } else *(u32x4*)(HB + (size_t)row * LDHB + 256 + bj * 128 + cw) = w;
                }
                if (u.pn == 0) { sq += __shfl_xor(sq, 16); sq += __shfl_xor(sq, 32); if (fq == 0) sqq[(size_t)row * 4 + wc] = sq; }
            }
    }
};
struct EpiKnope {
    static constexpr bool PERM = true, AFTER_DRAIN = false; bf16_t* K;
    __device__ __forceinline__ void operator()(const f32x4 (&acc)[2][2][4][2], const pg8::Unit& u, int wr, int wc, int fr, int fq) const {
        const int row0 = u.pm * 256 + wr * 64 + fr, d = wc * 32 + 8 * fq;
#pragma unroll
        for (int ai = 0; ai < 2; ++ai)
#pragma unroll
            for (int m = 0; m < 4; ++m)
#pragma unroll
                for (int bj = 0; bj < 2; ++bj) {
                    const int head = 2 * u.pn + bj;
                    u32x4 w; const f32x4 a = acc[ai][bj][m][0], b = acc[ai][bj][m][1];
                    w.x = pk2(a[0], a[1]); w.y = pk2(a[2], a[3]); w.z = pk2(b[0], b[1]); w.w = pk2(b[2], b[3]);
                    *(u32x4*)(K + ((size_t)head * S_ + row0 + ai * 128 + m * 16) * 192 + d) = w;
                }
    }
};
struct EpiQ {
    static constexpr bool PERM = true, AFTER_DRAIN = false; bf16_t* Q; const float2* tab; float qs; const float* sqq;
    __device__ __forceinline__ float rq(int row) const { const f32x4 s = *(const f32x4*)(sqq + (size_t)row * 4); return rsqrtf(((s[0] + s[1]) + (s[2] + s[3])) * (1.f / 256.f) + EPS) * qs; }
    __device__ __forceinline__ void operator()(const f32x4 (&acc)[2][2][4][2], const pg8::Unit& u, int wr, int wc, int fr, int fq) const {
        const int row0 = u.pm * 256 + wr * 64 + fr;
        if (u.pn < 3) {
            const int d = wc * 32 + 8 * fq;
#pragma unroll
            for (int ai = 0; ai < 2; ++ai)
#pragma unroll
                for (int m = 0; m < 4; ++m)
#pragma unroll
                    for (int bj = 0; bj < 2; ++bj) {
                        const int head = 2 * u.pn + bj;
                        u32x4 w; const f32x4 a = acc[ai][bj][m][0] * rq(row0 + ai * 128 + m * 16), b = acc[ai][bj][m][1] * rq(row0 + ai * 128 + m * 16);
                        w.x = pk2(a[0], a[1]); w.y = pk2(a[2], a[3]); w.z = pk2(b[0], b[1]); w.w = pk2(b[2], b[3]);
                        *(u32x4*)(Q + ((size_t)(row0 + ai * 128 + m * 16) * 6 + head) * 192 + d) = w;
                    }
        } else {
            const int head = 4 * (u.pn - 3) + wc;
            if (head < 6) {
#pragma unroll
                for (int ai = 0; ai < 2; ++ai)
#pragma unroll
                    for (int m = 0; m < 4; ++m) {
                        const int row = row0 + ai * 128 + m * 16;
                        float o1[8], o2[8]; const float qr = rq(row);
#pragma unroll
                        for (int n = 0; n < 2; ++n)
#pragma unroll
                            for (int j = 0; j < 4; ++j) {
                                const float2 cs = tab[(size_t)row * 32 + 8 * fq + 4 * n + j];
                                const float x1 = acc[ai][0][m][n][j], x2 = acc[ai][1][m][n][j];
                                o1[4 * n + j] = (x1 * cs.x - x2 * cs.y) * qr; o2[4 * n + j] = (x1 * cs.y + x2 * cs.x) * qr;
                            }
                        u32x4 w1, w2;
                        w1.x = pk2(o1[0], o1[1]); w1.y = pk2(o1[2], o1[3]); w1.z = pk2(o1[4], o1[5]); w1.w = pk2(o1[6], o1[7]);
                        w2.x = pk2(o2[0], o2[1]); w2.y = pk2(o2[2], o2[3]); w2.z = pk2(o2[4], o2[5]); w2.w = pk2(o2[6], o2[7]);
                        bf16_t* qp = Q + ((size_t)row * 6 + head) * 192 + 128 + 8 * fq;
                        *(u32x4*)qp = w1; *(u32x4*)(qp + 32) = w2;
                    }
            }
        }
    }
};

template <class Epi> __device__ __forceinline__ void run_gemm(ldsp lds, const bf16_t* A, const bf16_t* Bt, int M, int N, int K, int c, const Epi& E) {
    asm volatile("" : "+s"(M), "+s"(N), "+s"(K), "+s"(c));
    pg8::Gemm g{A, Bt, M, N, K}; pg8::StaticOrder S; S.init(M, N, (int)gridDim.x, c);
    pg8::gemm_phase<Epi, pg8::StaticOrder, true, true>(lds, g, S, E);
}

__device__ __forceinline__ int wmap(int map, int n, int nsrc) {
    switch (map) {
    case 0: return n < nsrc ? n : -1;
    case 1: { const int t = n >> 8, w = n & 255; return (w >> 7) * DFF + t * 128 + (w & 127); }
    case 2: { if (n < 768) return (n >> 7) * 192 + (n & 127);
              const int m = n - 768, t = m >> 8, w = m & 255, bj = w >> 7, cc = w & 127, head = 4 * t + (cc >> 5), jj = cc & 31;
              return head < 6 ? head * 192 + 128 + bj * 32 + jj : -1; }
    case 3: return n < 3084 ? n : (n >= QMA ? n - QMA + 3084 : -1);
    case 4: return (n >> 7) * 256 + (n & 127);
    default: return (n >> 7) * 256 + 128 + (n & 127);
    }
}
__device__ __forceinline__ void conv_job(const float* W, int K, int Nsrc, int Nout, int map, bf16_t* WT, LAS float* scr, int gw, int ngw, int lane, const float* gk = nullptr) {
    const int nblk = Nout / 32, nitems = (K / 64) * nblk;
    for (int it = gw; it < nitems; it += ngw) {
        const int kb = it / nblk, nb = it % nblk, k0 = 64 * kb, n0 = 32 * nb;
        const int sc = wmap(map, n0 + (lane & 31), Nsrc);
        float wv[32];
#pragma unroll
        for (int i = 0; i < 32; ++i) { const int kk = 2 * i + (lane >> 5); wv[i] = sc >= 0 ? W[(size_t)(k0 + kk) * Nsrc + sc] : 0.f; }
        if (gk) {
#pragma unroll
            for (int i = 0; i < 32; ++i) wv[i] *= gk[k0 + 2 * i + (lane >> 5)];
        }
#pragma unroll
        for (int i = 0; i < 32; ++i) { const int kk = 2 * i + (lane >> 5); scr[kk * 33 + (lane & 31)] = wv[i]; }
        asm volatile("s_waitcnt lgkmcnt(0)" ::: "memory");
        const int c = lane & 7;
#pragma unroll
        for (int j = 0; j < 4; ++j) { const int n = (lane >> 3) + 8 * j; const LAS float* s = scr + (8 * c) * 33 + n;
            u32x4 o; o.x = pk2(s[0 * 33], s[1 * 33]); o.y = pk2(s[2 * 33], s[3 * 33]); o.z = pk2(s[4 * 33], s[5 * 33]); o.w = pk2(s[6 * 33], s[7 * 33]);
            *(u32x4*)(WT + (size_t)(n0 + n) * K + k0 + 8 * c) = o; }
        asm volatile("s_waitcnt lgkmcnt(0)" ::: "memory");
    }
}
__device__ __forceinline__ void conv_group(const float* const* tin, unsigned char* wsb, int l, int group, ldsp lds, int gw, int ngw, int lane, int wid) {
    LAS float* scr = (LAS float*)(lds + wid * 16384);
    bf16_t* W = (bf16_t*)(wsb + WS_W);
    if (group == 0) {
        conv_job(gptr(tin + 4) + (size_t)l * D_ * NGU, D_, NGU, NGU, 1, W + WO_GU1, scr, gw, ngw, lane, gptr(tin + 3) + l * D_);
        conv_job(gptr(tin + 12) + (size_t)l * D_ * 512, D_, 512, 512, 0, W + WO_MKV, scr, gw, ngw, lane);
    } else if (group == 1) {
        conv_job(gptr(tin + 5) + (size_t)l * DFF * D_, DFF, D_, D_, 0, W + WO_D1, scr, gw, ngw, lane);
        if (l < 2) conv_job(gptr(tin + 13) + (size_t)l * D_ * 3340, D_, 3340, LDHA, 3, W + WO_IN, scr, gw, ngw, lane, gptr(tin + 6) + l * D_);
        else { conv_job(gptr(tin + 18) + (size_t)(l - 2) * D_ * 512, D_, 512, 512, 0, W + WO_IN, scr, gw, ngw, lane, gptr(tin + 6) + l * D_);
               conv_job(gptr(tin + 20) + (size_t)(l - 2) * 256 * 1152, 256, 1152, 1280, 2, W + WO_UQ, scr, gw, ngw, lane, gptr(tin + 19) + (l - 2) * 256); }
        conv_job(gptr(tin + 10) + (size_t)l * D_ * D_, D_, D_, D_, 0, W + WO_OUT, scr, gw, ngw, lane);
    } else {
        conv_job(gptr(tin + 8) + (size_t)l * D_ * NGU, D_, NGU, NGU, 1, W + WO_GU2, scr, gw, ngw, lane, gptr(tin + 7) + l * D_);
        conv_job(gptr(tin + 9) + (size_t)l * DFF * D_, DFF, D_, D_, 0, W + WO_D2, scr, gw, ngw, lane);
    }
}

__device__ __forceinline__ void rms_row_bf16(const float* xrow, const float* g, bf16_t* orow, int lane) {
    f32x4 v[4]; float s = 0.f;
#pragma unroll
    for (int j = 0; j < 4; ++j) { v[j] = *(const f32x4*)(xrow + 4 * lane + 256 * j); s += (v[j][0] * v[j][0] + v[j][1] * v[j][1]) + (v[j][2] * v[j][2] + v[j][3] * v[j][3]); }
    const float r = rsqrtf(wave_sum(s) * (1.f / D_) + EPS);
#pragma unroll
    for (int j = 0; j < 4; ++j) { const f32x4 gg = *(const f32x4*)(g + 4 * lane + 256 * j);
        u32x2 w; w.x = pk2(v[j][0] * r * gg[0], v[j][1] * r * gg[1]); w.y = pk2(v[j][2] * r * gg[2], v[j][3] * r * gg[3]);
        *(u32x2*)(orow + 4 * lane + 256 * j) = w; }
}
__device__ __forceinline__ void norm_rows(const float* x, const float* g, bf16_t* xn, int nrows, int gw, int ngw, int lane) {
    for (int m = gw; m < nrows; m += ngw) rms_row_bf16(x + (size_t)m * D_, g, xn + (size_t)m * D_, lane);
}

template <int I> struct SolveRow {
    static __device__ __forceinline__ void run(float (&t)[64], const float (&a)[64], float lanef) {
        SolveRow<I - 1>::run(t, a, lanef);
        float s0 = __builtin_amdgcn_fmed3f(1.f - fabsf(lanef - (float)I), 0.f, 1.f), s1 = 0.f, s2 = 0.f, s3 = 0.f;
        const int ai = __float_as_int(a[I]);
#pragma unroll
        for (int j = 0; j < I; ++j) {
            const float aj = __int_as_float(__builtin_amdgcn_readlane(ai, j));
            if ((j & 3) == 0) s0 -= aj * t[j]; else if ((j & 3) == 1) s1 -= aj * t[j]; else if ((j & 3) == 2) s2 -= aj * t[j]; else s3 -= aj * t[j];
        }
        t[I] = (s0 + s1) + (s2 + s3);
    }
};
template <> struct SolveRow<0> { static __device__ __forceinline__ void run(float (&)[64], const float (&)[64], float) {} };
constexpr int PL_AS = 0, PL_TINV = 16384, PL_GC = 24576, PL_BETA = 24832, PL_QS = 32768, PL_KS = 49152, PL_KTS = 65536, PL_VTS = 81920;
__device__ __forceinline__ void gdn_prep_unit(ldsp L, int u, const bf16_t* hA, const float* convw, float Aexp, float dtb,
                                             bf16_t* negw, bf16_t* qd, bf16_t* kdT, bf16_t* qk, bf16_t* uT, float* dch, int tid, int wid, int lane) {
    const int n = u / 6, h = u - 6 * n, t0 = 64 * n, fr = lane & 15, fq = lane >> 4;
    const int us = h * 256 + n;
    LAS float* GC = (LAS float*)(L + PL_GC); LAS float* BETA = (LAS float*)(L + PL_BETA); LAS float* AS = (LAS float*)(L + PL_AS);
    float beta, gc, glast;
    {
        const bf16_t* rowp = hA + (size_t)(t0 + lane) * LDHA;
        const float braw = bf2f(rowp[3072 + h]), araw = bf2f(rowp[3078 + h]);
        beta = 1.f / (1.f + __expf(-braw));
        const float xs = araw + dtb; const float sp = xs > 20.f ? xs : log1pf(__expf(xs));
        gc = -Aexp * sp;
#pragma unroll
        for (int o = 1; o < 64; o <<= 1) { const float t = __shfl_up(gc, o); if (lane >= o) gc += t; }
        glast = __shfl(gc, 63);
        if (wid == 0) { GC[lane] = gc; BETA[lane] = beta; }
    }
#pragma unroll
    for (int tt = 0; tt < 3; ++tt) {
        const int cb = tt * 768 + h * 128 + 2 * lane;
        float w0[4], w1[4];
#pragma unroll
        for (int k = 0; k < 4; ++k) { const float2 wv = *(const float2*)(convw + k * 2304 + cb); w0[k] = wv.x; w1[k] = wv.y; }
        float x0[11], x1[11];
#pragma unroll
        for (int r = 0; r < 11; ++r) { const int row = t0 + 8 * wid - 3 + r; unsigned v = 0u; if (row >= 0) v = *(const unsigned*)(hA + (size_t)row * LDHA + cb); x0[r] = bflo(v); x1[r] = bfhi(v); }
#pragma unroll
        for (int i = 0; i < 8; ++i) {
            float a0 = 0.f, a1 = 0.f;
#pragma unroll
            for (int k = 0; k < 4; ++k) { a0 += w0[k] * x0[i + k]; a1 += w1[k] * x1[i + k]; }
            a0 = silu_f(a0); a1 = silu_f(a1);
            const int il = 8 * wid + i;
            const float bi = __shfl(beta, il), gi = __shfl(gc, il);
            if (tt < 2) {
                const float ss = wave_sum(a0 * a0 + a1 * a1);
                float rn = rsqrtf(ss + EPS); if (tt == 0) rn *= 0.08838834764831845f;
                a0 *= rn; a1 *= rn;
                *(LAS unsigned*)(L + (tt == 0 ? PL_QS : PL_KS) + swzA(il, lane >> 2) + (lane & 3) * 4) = pk2(a0, a1);
                if (tt == 1) { const float sc = bi * __expf(gi); const unsigned w = pk2(a0 * sc, a1 * sc);
                    *(LAS bf16_t*)(L + PL_KTS + swzB(2 * lane, il >> 3) + (il & 7) * 2) = (bf16_t)(w & 0xffffu);
                    *(LAS bf16_t*)(L + PL_KTS + swzB(2 * lane + 1, il >> 3) + (il & 7) * 2) = (bf16_t)(w >> 16); }
            } else {
                const unsigned w = pk2(a0 * bi, a1 * bi);
                *(LAS bf16_t*)(L + PL_VTS + swzB(2 * lane, il >> 3) + (il & 7) * 2) = (bf16_t)(w & 0xffffu);
                *(LAS bf16_t*)(L + PL_VTS + swzB(2 * lane + 1, il >> 3) + (il & 7) * 2) = (bf16_t)(w >> 16);
            }
        }
    }
    __syncthreads();
#pragma unroll
    for (int pp = 0; pp < 2; ++pp) {
        const int pr = wid + 8 * pp, it = pr >> 2, jt = pr & 3;
        f32x4 accA = {0.f, 0.f, 0.f, 0.f}, accQ = {0.f, 0.f, 0.f, 0.f};
        if (jt <= it) {
#pragma unroll
            for (int s = 0; s < 4; ++s) {
                const bf16x8 X = ldsfrag(L + PL_KS + swzA(16 * jt + fr, 4 * s + fq));
                const bf16x8 Yk = ldsfrag(L + PL_KS + swzA(16 * it + fr, 4 * s + fq));
                const bf16x8 Yq = ldsfrag(L + PL_QS + swzA(16 * it + fr, 4 * s + fq));
                accA = mma(X, Yk, accA); accQ = mma(X, Yq, accQ);
            }
        }
        const int i = 16 * it + fr; const float gci = GC[i], bi = BETA[i];
        f32x4 av, qv;
#pragma unroll
        for (int r = 0; r < 4; ++r) { const int j = 16 * jt + 4 * fq + r; const float dec = __expf(gci - GC[j]);
            av[r] = (j < i) ? bi * accA[r] * dec : 0.f; qv[r] = (j <= i) ? accQ[r] * dec : 0.f; }
        if (jt <= it) *(LAS f32x4*)(AS + i * 64 + 16 * jt + 4 * fq) = av;
        *(u32x2*)(qk + (size_t)us * 4096 + i * 64 + 32 * (jt >> 1) + 8 * fq + 4 * (jt & 1)) = pack4(qv);
    }
    __syncthreads();
    if (wid == 0) {
        float t[64]; const float lanef = (float)lane;
        unsigned asb_ = (unsigned)(uintptr_t)(L + PL_AS); asm volatile("" : "+v"(asb_)); const ldsp asb = (ldsp)asb_;
#pragma unroll
        for (int i = 0; i < 64; ++i) t[i] = 0.f;
        t[0] = __builtin_amdgcn_fmed3f(1.f - fabsf(lanef), 0.f, 1.f);
        float arow[64];
#pragma unroll
        for (int i = 0; i < 64; ++i) arow[i] = *(LAS float*)(asb + (i * 64) * 4 + lane * 4);
        SolveRow<63>::run(t, arow, lanef);
#pragma unroll
        for (int i = 0; i < 64; ++i) *(LAS bf16_t*)(L + PL_TINV + swzB(i, lane >> 3) + (lane & 7) * 2) = (bf16_t)(pk2(t[i], 0.f) & 0xffffu);
        if (lane == 0) dch[us] = __expf(glast);
    } else {
        const int t7 = tid - 64;
        for (int it = t7; it < 1024; it += 448) {
            const int c = it >> 4, oc = it & 15, s = oc >> 2, fqq = oc & 3, d1 = 32 * s + 4 * fqq, d2 = d1 + 16;
            const u32x2 a = *(LAS u32x2*)(L + PL_QS + swzA(c, d1 >> 3) + (d1 & 7) * 2), b = *(LAS u32x2*)(L + PL_QS + swzA(c, d2 >> 3) + (d2 & 7) * 2);
            const float e = __expf(GC[c]);
            u32x4 w; w.x = pk2(bflo(a.x) * e, bfhi(a.x) * e); w.y = pk2(bflo(a.y) * e, bfhi(a.y) * e); w.z = pk2(bflo(b.x) * e, bfhi(b.x) * e); w.w = pk2(bflo(b.y) * e, bfhi(b.y) * e);
            *(u32x4*)(qd + (size_t)us * 8192 + c * 128 + 8 * oc) = w;
        }
        for (int it = t7; it < 1024; it += 448) {
            const int d = it >> 3, oc = it & 7, s = oc >> 2, fqq = oc & 3;
            float v[8];
#pragma unroll
            for (int a = 0; a < 2; ++a)
#pragma unroll
                for (int b = 0; b < 4; ++b) { const int c = 32 * s + 16 * a + 4 * fqq + b;
                    v[4 * a + b] = bf2f(*(LAS bf16_t*)(L + PL_KS + swzA(c, d >> 3) + (d & 7) * 2)) * __expf(glast - GC[c]); }
            u32x4 w; w.x = pk2(v[0], v[1]); w.y = pk2(v[2], v[3]); w.z = pk2(v[4], v[5]); w.w = pk2(v[6], v[7]);
            *(u32x4*)(kdT + (size_t)us * 8192 + d * 64 + 8 * oc) = w;
        }
    }
    __syncthreads();
    {
        const int ct = wid >> 1;
        bf16x8 yt[2];
#pragma unroll
        for (int s2 = 0; s2 < 2; ++s2) yt[s2] = ldsfrag(L + PL_TINV + swzB(16 * ct + fr, 4 * s2 + fq));
#pragma unroll
        for (int q = 0; q < 4; ++q) {
            const int dt = 4 * (wid & 1) + q; f32x4 acc = {0.f, 0.f, 0.f, 0.f};
#pragma unroll
            for (int s2 = 0; s2 < 2; ++s2) acc = mma(ldsfrag(L + PL_KTS + swzB(16 * dt + fr, 4 * s2 + fq)), yt[s2], acc);
            acc = -acc;
            *(u32x2*)(negw + (size_t)us * 8192 + (16 * ct + fr) * 128 + 32 * (dt >> 1) + 8 * fq + 4 * (dt & 1)) = pack4(acc);
        }
        const int et = wid;
        bf16x8 yv[2];
#pragma unroll
        for (int s2 = 0; s2 < 2; ++s2) yv[s2] = ldsfrag(L + PL_VTS + swzB(16 * et + fr, 4 * s2 + fq));
#pragma unroll
        for (int c4 = 0; c4 < 4; ++c4) {
            f32x4 acc = {0.f, 0.f, 0.f, 0.f};
#pragma unroll
            for (int s2 = 0; s2 < 2; ++s2) acc = mma(ldsfrag(L + PL_TINV + swzB(16 * c4 + fr, 4 * s2 + fq)), yv[s2], acc);
            *(u32x2*)(uT + (size_t)us * 8192 + (16 * et + fr) * 64 + 16 * c4 + 4 * fq) = pack4(acc);
        }
    }
    __syncthreads();
}

constexpr int SC_BUF = 57344, SC_NEGW = 0, SC_QD = 16384, SC_KDT = 32768, SC_QK = 49152;
#define SCB() __builtin_amdgcn_sched_barrier(0)
__device__ __forceinline__ void scan_step(ldsp B, f32x4 (&S)[8], const u32x2 (&uc)[4], float dc, bf16_t* orow, int fr, int fq) {
    bf16x8 fa[8], fb[8];
    bf16x8 ys[4];
#pragma unroll
    for (int s = 0; s < 4; ++s) ys[s] = pack8(S[2 * s], S[2 * s + 1]);
    f32x4 vn[4], o[4];
#pragma unroll
    for (int ct = 0; ct < 4; ++ct) { vn[ct] = (f32x4){bflo(uc[ct].x), bfhi(uc[ct].x), bflo(uc[ct].y), bfhi(uc[ct].y)}; o[ct] = (f32x4){0.f, 0.f, 0.f, 0.f}; }
#define LD_P1(dst, s) do { _Pragma("unroll") for (int ct = 0; ct < 4; ++ct) { dst[ct] = ldsfrag(B + SC_NEGW + swzA(16 * ct + fr, 4 * (s) + fq)); dst[4 + ct] = ldsfrag(B + SC_QD + swzA(16 * ct + fr, 4 * (s) + fq)); } } while (0)
#define MM_P1(src, s) do { _Pragma("unroll") for (int ct = 0; ct < 4; ++ct) { vn[ct] = mma(src[ct], ys[s], vn[ct]); o[ct] = mma(src[4 + ct], ys[s], o[ct]); } } while (0)
#define LD_KD(dst, d0) do { _Pragma("unroll") for (int q = 0; q < 4; ++q) { dst[2 * q] = ldsfrag(B + SC_KDT + swzB(16 * ((d0) + q) + fr, fq)); dst[2 * q + 1] = ldsfrag(B + SC_KDT + swzB(16 * ((d0) + q) + fr, 4 + fq)); } } while (0)
#define MM_KD(src, d0) do { _Pragma("unroll") for (int q = 0; q < 4; ++q) { S[(d0) + q] = mma(src[2 * q], yv[0], S[(d0) + q]); } _Pragma("unroll") for (int q = 0; q < 4; ++q) { S[(d0) + q] = mma(src[2 * q + 1], yv[1], S[(d0) + q]); } } while (0)
    LD_P1(fa, 0); SCB();
    LD_P1(fb, 1); SCB(); MM_P1(fa, 0); SCB();
    LD_P1(fa, 2); SCB(); MM_P1(fb, 1); SCB();
    LD_P1(fb, 3); SCB(); MM_P1(fa, 2); SCB();
    LD_KD(fa, 0); SCB(); MM_P1(fb, 3); SCB();
#pragma unroll
    for (int dt = 0; dt < 8; ++dt) S[dt] = S[dt] * dc;
    LD_KD(fb, 4); SCB();
    bf16x8 yv[2];
#pragma unroll
    for (int s2 = 0; s2 < 2; ++s2) yv[s2] = pack8(vn[2 * s2], vn[2 * s2 + 1]);
    MM_KD(fa, 0); SCB();
#pragma unroll
    for (int ct = 0; ct < 4; ++ct) { fa[2 * ct] = ldsfrag(B + SC_QK + swzB(16 * ct + fr, fq)); fa[2 * ct + 1] = ldsfrag(B + SC_QK + swzB(16 * ct + fr, 4 + fq)); }
    SCB(); MM_KD(fb, 4); SCB();
#pragma unroll
    for (int ct = 0; ct < 4; ++ct) o[ct] = mma(fa[2 * ct], yv[0], o[ct]);
#pragma unroll
    for (int ct = 0; ct < 4; ++ct) o[ct] = mma(fa[2 * ct + 1], yv[1], o[ct]);
#pragma unroll
    for (int ct = 0; ct < 4; ++ct)
#pragma unroll
        for (int r = 0; r < 4; ++r) orow[(size_t)(16 * ct + 4 * fq + r) * LDHA] = (bf16_t)(pk2(o[ct][r], 0.f) & 0xffffu);
#undef LD_P1
#undef MM_P1
#undef LD_KD
#undef MM_KD
}
__device__ __forceinline__ void gdn_scan(ldsp L, int h, int eq, const bf16_t* negw, const bf16_t* qd, const bf16_t* kdT, const bf16_t* qk, const bf16_t* uT, const float* dch,
                                        bf16_t* hA, int tid, int wid, int lane) {
#define SC_BAR() asm volatile("s_waitcnt lgkmcnt(0)\n\ts_barrier" ::: "memory")
    const int fr = lane & 15, fq = lane >> 4, e0 = 32 * eq + 16 * wid;
    if (wid < 2) {
        f32x4 S[8];
#pragma unroll
        for (int d = 0; d < 8; ++d) S[d] = (f32x4){0.f, 0.f, 0.f, 0.f};
        u32x2 ua[4], ub[4]; float da, db;
#define SC_LOADU(un, dcn, nn) do { const size_t u_ = (size_t)h * 256 + (nn); \
        _Pragma("unroll") for (int ct = 0; ct < 4; ++ct) un[ct] = *(const u32x2*)(uT + u_ * 8192 + (size_t)(e0 + fr) * 64 + 16 * ct + 4 * fq); dcn = dch[u_]; } while (0)
        SC_LOADU(ua, da, 0); SC_LOADU(ub, db, 1);
        SC_BAR();
        for (int n = 0; n < 256; n += 2) {
            { u32x2 uc[4]; const float dc = da;
#pragma unroll
              for (int ct = 0; ct < 4; ++ct) uc[ct] = ua[ct];
              SC_LOADU(ua, da, (n + 2 < 256 ? n + 2 : 255));
              scan_step(L, S, uc, dc, hA + (size_t)(64 * n) * LDHA + h * 128 + e0 + fr, fr, fq);
              SC_BAR(); }
            { u32x2 uc[4]; const float dc = db;
#pragma unroll
              for (int ct = 0; ct < 4; ++ct) uc[ct] = ub[ct];
              SC_LOADU(ub, db, (n + 3 < 256 ? n + 3 : 255));
              scan_step(L + SC_BUF, S, uc, dc, hA + (size_t)(64 * (n + 1)) * LDHA + h * 128 + e0 + fr, fr, fq);
              SC_BAR(); }
        }
#undef SC_LOADU
    } else {
        const int w6 = wid - 2;
        u32x4 ra[10], rb[10];
#define SC_LOADS(r, nn) do { const size_t u_ = (size_t)h * 256 + (nn); \
        _Pragma("unroll") for (int i_ = 0; i_ < 10; ++i_) { const int idx_ = (w6 + 6 * i_) < 56 ? (w6 + 6 * i_) : 55; { const int a_ = idx_ >> 4, c_ = (idx_ & 15) * 64 + lane; \
            const bf16_t* b_ = a_ == 0 ? negw : a_ == 1 ? qd : a_ == 2 ? kdT : qk; \
            r[i_] = *(const u32x4*)(b_ + u_ * (a_ == 3 ? 4096 : 8192) + (size_t)c_ * 8); } } } while (0)
#define SC_STORES(r, buf) do { ldsp B_ = L + (buf) * SC_BUF; \
        _Pragma("unroll") for (int i_ = 0; i_ < 10; ++i_) { const int idx_ = (w6 + 6 * i_) < 56 ? (w6 + 6 * i_) : 55; { const int a_ = idx_ >> 4, c_ = (idx_ & 15) * 64 + lane; \
            const int off_ = a_ < 2 ? a_ * 16384 + swzA(c_ >> 4, c_ & 15) : (a_ == 2 ? SC_KDT : SC_QK) + swzB(c_ >> 3, c_ & 7); \
            *(LAS u32x4*)(B_ + off_) = r[i_]; } } } while (0)
        SC_LOADS(ra, 0); SC_STORES(ra, 0);
        SC_LOADS(rb, 1); SC_LOADS(ra, 2);
        SC_BAR();
        for (int n = 0; n < 256; n += 2) {
            SC_STORES(rb, 1);
            SC_LOADS(rb, (n + 3 < 256 ? n + 3 : 255));
            SC_BAR();
            SC_STORES(ra, 0);
            SC_LOADS(ra, (n + 4 < 256 ? n + 4 : 255));
            SC_BAR();
        }
#undef SC_LOADS
#undef SC_STORES
    }
}
#undef SC_BAR

__device__ __forceinline__ void gdn_out_rows(const bf16_t* hA, const float* gain, bf16_t* mix, int gw, int ngw, int lane) {
    const float2 gg = *(const float2*)(gain + 2 * lane);
    for (int m0 = gw; m0 < S_; m0 += 2 * ngw) {
        unsigned ov[2][6], gv[2][6];
#pragma unroll
        for (int q = 0; q < 2; ++q) {
            const int m = m0 + q * ngw < S_ ? m0 + q * ngw : m0;
            const bf16_t* rowp = hA + (size_t)m * LDHA;
#pragma unroll
            for (int h = 0; h < 6; ++h) { ov[q][h] = *(const unsigned*)(rowp + h * 128 + 2 * lane); gv[q][h] = *(const unsigned*)(rowp + 2304 + h * 128 + 2 * lane); }
        }
#pragma unroll
        for (int q = 0; q < 2; ++q) {
            const int m = m0 + q * ngw;
            if (m < S_) {
#pragma unroll
                for (int h = 0; h < 6; ++h) {
                    const float o0 = bflo(ov[q][h]), o1 = bfhi(ov[q][h]);
                    const float r = rsqrtf(wave_sum(o0 * o0 + o1 * o1) * (1.f / 128.f) + EPS);
                    *(unsigned*)(mix + (size_t)m * D_ + h * 128 + 2 * lane) = pk2(o0 * r * gg.x * silu_f(bflo(gv[q][h])), o1 * r * gg.y * silu_f(bfhi(gv[q][h])));
                }
            }
        }
    }
}

__device__ __forceinline__ int swzV(int r, int ch) { return r * 512 + ((ch ^ (r & 15)) << 4); }
__device__ __forceinline__ void mem_attn(ldsp L, const bf16_t* qsrc, int ldq, int qcol, const bf16_t* memK, const bf16_t* memVt, bf16_t* mix, int tid, int wid, int lane) {
    const int fr = lane & 15, fq = lane >> 4;
    const float SCL = 0.125f * 1.4426950408889634f;
    for (int unit = blockIdx.x; unit < 256; unit += gridDim.x) {
        const int hm = unit & 3, tb = unit >> 2;
#pragma unroll
        for (int i = 0; i < 4; ++i) { const int g = tid + 512 * i;
            *(LAS u32x4*)(L + swzB(g >> 3, g & 7)) = *(const u32x4*)(memK + (size_t)(g >> 3) * 256 + hm * 64 + (g & 7) * 8);
            *(LAS u32x4*)(L + 32768 + swzV(g >> 5, g & 31)) = *(const u32x4*)(memVt + (size_t)(hm * 64 + (g >> 5)) * 256 + (g & 31) * 8); }
        __syncthreads();
        for (int tl = wid; tl < 16; tl += NW) {
            const int tok0 = 256 * tb + 16 * tl;
            bf16x8 yq[2];
#pragma unroll
            for (int s = 0; s < 2; ++s) yq[s] = gfrag(qsrc + (size_t)(tok0 + fr) * ldq + qcol + hm * 64 + 32 * s + 8 * fq);
            f32x4 sc[16];
#pragma unroll
            for (int kb = 0; kb < 4; ++kb) {
                bf16x8 xk[8];
#pragma unroll
                for (int q = 0; q < 4; ++q) { xk[2 * q] = ldsfrag(L + swzB(16 * (4 * kb + q) + fr, fq)); xk[2 * q + 1] = ldsfrag(L + swzB(16 * (4 * kb + q) + fr, 4 + fq)); }
                SCB();
#pragma unroll
                for (int q = 0; q < 4; ++q) { sc[4 * kb + q] = mma(xk[2 * q], yq[0], (f32x4){0.f, 0.f, 0.f, 0.f}); sc[4 * kb + q] = mma(xk[2 * q + 1], yq[1], sc[4 * kb + q]); }
                SCB();
            }
            float mx = -1e30f;
#pragma unroll
            for (int kt = 0; kt < 16; ++kt)
#pragma unroll
                for (int r = 0; r < 4; ++r) mx = fmaxf(mx, sc[kt][r]);
            mx = fmaxf(mx, __shfl_xor(mx, 16)); mx = fmaxf(mx, __shfl_xor(mx, 32));
            float l = 0.f;
#pragma unroll
            for (int kt = 0; kt < 16; ++kt)
#pragma unroll
                for (int r = 0; r < 4; ++r) { const float pv = __builtin_amdgcn_exp2f((sc[kt][r] - mx) * SCL); sc[kt][r] = pv; l += pv; }
            l += __shfl_xor(l, 16); l += __shfl_xor(l, 32);
            const float rl = 1.f / l;
            f32x4 o[4];
#pragma unroll
            for (int dt = 0; dt < 4; ++dt) o[dt] = (f32x4){0.f, 0.f, 0.f, 0.f};
#pragma unroll
            for (int s = 0; s < 8; ++s) {
                const bf16x8 yp = pack8(sc[2 * s], sc[2 * s + 1]);
                bf16x8 xv[4];
#pragma unroll
                for (int dt = 0; dt < 4; ++dt) xv[dt] = ldsfrag(L + 32768 + swzV(16 * dt + fr, 4 * s + fq));
                SCB();
#pragma unroll
                for (int dt = 0; dt < 4; ++dt) o[dt] = mma(xv[dt], yp, o[dt]);
                SCB();
            }
#pragma unroll
            for (int dt = 0; dt < 4; ++dt) *(u32x2*)(mix + (size_t)(tok0 + fr) * D_ + 768 + hm * 64 + 16 * dt + 4 * fq) = pack4(o[dt] * rl);
        }
        __syncthreads();
    }
}

constexpr int AT_BUF = 40960, AT_KN = 0, AT_KR = 16384, AT_VT = 24576, AT_CTL = 2 * AT_BUF, AT_QR = 2 * AT_BUF + 1024;
__device__ __forceinline__ void mla_attn(ldsp L, const bf16_t* Qc, const bf16_t* Kc, const bf16_t* Vt, bf16_t* mix, unsigned* ctr, int tid, int wid, int lane) {
    const int fr = lane & 15, fq = lane >> 4;
    LAS int* ctl = (LAS int*)(L + AT_CTL);
    for (;;) {
        if (tid == 0) ctl[0] = (int)atomicAdd(ctr, 1u);
        __syncthreads();
        const int item = ctl[0];
        __syncthreads();
        if (item >= 384) break;
        const int qb = 63 - item / 6, h = item % 6;
        const int NT = 4 * qb + 4, q0 = 256 * qb + 32 * wid, tmax = 4 * qb + (wid >> 1);
        bf16x8 Q[2][4];
        const bf16_t* qrow = Qc + ((size_t)(q0 + fr) * 6 + h) * 192 + 8 * fq;
#pragma unroll
        for (int qs = 0; qs < 2; ++qs)
#pragma unroll
            for (int s = 0; s < 4; ++s) Q[qs][s] = gfrag(qrow + (size_t)qs * 16 * 1152 + 32 * s);
#pragma unroll
        for (int qs = 0; qs < 2; ++qs)
#pragma unroll
            for (int s = 0; s < 2; ++s) *(LAS bf16x8*)(L + AT_QR + wid * 4096 + (qs * 2 + s) * 1024 + lane * 16) = gfrag(qrow + (size_t)qs * 16 * 1152 + 128 + 32 * s);
        f32x4 O[2][8];
#pragma unroll
        for (int qs = 0; qs < 2; ++qs)
#pragma unroll
            for (int dt = 0; dt < 8; ++dt) O[qs][dt] = (f32x4){0.f, 0.f, 0.f, 0.f};
        float mrow[2] = {0.f, 0.f}, lrow[2] = {0.f, 0.f};
        const bf16_t* Kh = Kc + (size_t)h * S_ * 192; const bf16_t* Vh = Vt + (size_t)h * 128 * S_;
        const int rA = lane >> 4, cA = lane & 15, rB = lane >> 3, cB = lane & 7;
#define AT_DMA(t, buf) do { ldsp B_ = L + (buf) * AT_BUF; const size_t kb_ = (size_t)(t) * 64; \
        _Pragma("unroll") for (int i_ = 0; i_ < 2; ++i_) { const int pi_ = wid + 8 * i_, r_ = 4 * pi_ + rA; \
            __builtin_amdgcn_global_load_lds((const unsigned*)(Kh + (kb_ + r_) * 192 + ((cA ^ (r_ & 15)) << 3)), (LAS unsigned*)(B_ + AT_KN + pi_ * 1024), 16, 0, 0); } \
        { const int r_ = 8 * wid + rB; \
            __builtin_amdgcn_global_load_lds((const unsigned*)(Kh + (kb_ + r_) * 192 + 128 + ((cB ^ (r_ & 7)) << 3)), (LAS unsigned*)(B_ + AT_KR + wid * 1024), 16, 0, 0); } \
        _Pragma("unroll") for (int i_ = 0; i_ < 2; ++i_) { const int pi_ = wid + 8 * i_, r_ = 8 * pi_ + rB; \
            __builtin_amdgcn_global_load_lds((const unsigned*)(Vh + (size_t)r_ * S_ + kb_ + ((cB ^ (r_ & 7)) << 3)), (LAS unsigned*)(B_ + AT_VT + pi_ * 1024), 16, 0, 0); } } while (0)
        AT_DMA(0, 0);
        asm volatile("s_waitcnt vmcnt(0)" ::: "memory");
        __syncthreads();
        for (int t = 0; t < NT; ++t) {
            if (t + 1 < NT) AT_DMA(t + 1, (t + 1) & 1);
            if (t <= tmax) {
                ldsp B = L + (t & 1) * AT_BUF;
                f32x4 sc[2][4];
                bf16x8 Qr[2][2];
#pragma unroll
                for (int qs = 0; qs < 2; ++qs)
#pragma unroll
                    for (int s = 0; s < 2; ++s) Qr[qs][s] = ldsfrag(L + AT_QR + wid * 4096 + (qs * 2 + s) * 1024 + lane * 16);
                bf16x8 xa[6], v0[8];
#define AT_LDK(dst, kt) do { _Pragma("unroll") for (int s = 0; s < 4; ++s) dst[s] = ldsfrag(B + AT_KN + swzA(16 * (kt) + fr, 4 * s + fq)); \
                             dst[4] = ldsfrag(B + AT_KR + swzB(16 * (kt) + fr, fq)); dst[5] = ldsfrag(B + AT_KR + swzB(16 * (kt) + fr, 4 + fq)); } while (0)
#define AT_MMK(src, kt) do { sc[0][kt] = (f32x4){-mrow[0], -mrow[0], -mrow[0], -mrow[0]}; sc[1][kt] = (f32x4){-mrow[1], -mrow[1], -mrow[1], -mrow[1]}; \
                             _Pragma("unroll") for (int s = 0; s < 4; ++s) { sc[0][kt] = mma(src[s], Q[0][s], sc[0][kt]); sc[1][kt] = mma(src[s], Q[1][s], sc[1][kt]); } \
                             _Pragma("unroll") for (int s = 0; s < 2; ++s) { sc[0][kt] = mma(src[4 + s], Qr[0][s], sc[0][kt]); sc[1][kt] = mma(src[4 + s], Qr[1][s], sc[1][kt]); } } while (0)
#define AT_LDV(dst, d0) do { _Pragma("unroll") for (int q = 0; q < 4; ++q) { dst[2 * q] = ldsfrag(B + AT_VT + swzB(16 * ((d0) + q) + fr, fq)); dst[2 * q + 1] = ldsfrag(B + AT_VT + swzB(16 * ((d0) + q) + fr, 4 + fq)); } } while (0)
#define AT_MMV(src, d0) do { _Pragma("unroll") for (int q = 0; q < 4; ++q) { \
                             O[0][(d0) + q] = mma(src[2 * q], yp[0][0], O[0][(d0) + q]); O[1][(d0) + q] = mma(src[2 * q], yp[1][0], O[1][(d0) + q]); } \
                             _Pragma("unroll") for (int q = 0; q < 4; ++q) { \
                             O[0][(d0) + q] = mma(src[2 * q + 1], yp[0][1], O[0][(d0) + q]); O[1][(d0) + q] = mma(src[2 * q + 1], yp[1][1], O[1][(d0) + q]); } } while (0)
                AT_LDK(xa, 0); SCB(); AT_MMK(xa, 0); SCB();
                AT_LDK(xa, 1); SCB(); AT_MMK(xa, 1); SCB();
                AT_LDK(xa, 2); SCB(); AT_MMK(xa, 2); SCB();
                AT_LDK(xa, 3); SCB(); AT_MMK(xa, 3); SCB(); AT_LDV(v0, 0); SCB();
                bf16x8 yp[2][2];
#pragma unroll
                for (int qs = 0; qs < 2; ++qs) {
                    float mx = -1e30f;
#pragma unroll
                    for (int kt = 0; kt < 4; ++kt)
#pragma unroll
                        for (int r = 0; r < 4; ++r) mx = fmaxf(mx, sc[qs][kt][r]);
                    mx = fmaxf(mx, __shfl_xor(mx, 16)); mx = fmaxf(mx, __shfl_xor(mx, 32));
                    if (__any(t == 0 || mx > 8.f)) {
                        const float dl = t == 0 ? mx : fmaxf(mx, 0.f), alpha = __builtin_amdgcn_exp2f(-dl);
                        mrow[qs] += dl; lrow[qs] *= alpha;
#pragma unroll
                        for (int kt = 0; kt < 4; ++kt) sc[qs][kt] = sc[qs][kt] - dl;
#pragma unroll
                        for (int dt = 0; dt < 8; ++dt) O[qs][dt] = O[qs][dt] * alpha;
                    }
                    float ls = 0.f;
#pragma unroll
                    for (int kt = 0; kt < 4; ++kt)
#pragma unroll
                        for (int r = 0; r < 4; ++r) { const float pv = __builtin_amdgcn_exp2f(sc[qs][kt][r]); sc[qs][kt][r] = pv; ls += pv; }
                    lrow[qs] += ls;
                    yp[qs][0] = pack8(sc[qs][0], sc[qs][1]); yp[qs][1] = pack8(sc[qs][2], sc[qs][3]);
                }
                SCB(); AT_MMV(v0, 0); SCB(); AT_LDV(v0, 4); SCB(); AT_MMV(v0, 4); SCB();
#undef AT_LDK
#undef AT_MMK
#undef AT_LDV
#undef AT_MMV
            }
            asm volatile("s_waitcnt vmcnt(0)" ::: "memory");
            __syncthreads();
        }
#undef AT_DMA
#pragma unroll
        for (int qs = 0; qs < 2; ++qs) {
            float l = lrow[qs]; l += __shfl_xor(l, 16); l += __shfl_xor(l, 32);
            const float rl = 1.f / l;
#pragma unroll
            for (int dt = 0; dt < 8; ++dt) *(u32x2*)(mix + (size_t)(q0 + 16 * qs + fr) * D_ + h * 128 + 16 * dt + 4 * fq) = pack4(O[qs][dt] * rl);
        }
    }
}


#define XB_TMO      128
#define XB_XCNT(j)  (256  + 64 * (j))
#define XB_XSUB(j)  (1280 + 64 * (j))
#define XB_XGEN(j)  (2304 + 64 * (j))
#define XB_TOP      3328
#define XB_TOPGEN   3392
#define XCD_BAR_WORDS 3456
#define XB_SPIN_CAP (1u << 18)

__device__ __forceinline__ unsigned xb_ld(unsigned* p)              { return __hip_atomic_load(p, __ATOMIC_RELAXED, __HIP_MEMORY_SCOPE_AGENT); }
__device__ __forceinline__ unsigned xb_add(unsigned* p, unsigned v) { return __hip_atomic_fetch_add(p, v, __ATOMIC_RELAXED, __HIP_MEMORY_SCOPE_AGENT); }
__device__ __forceinline__ unsigned xb_xcc_id() { return (unsigned)__builtin_amdgcn_s_getreg((3 << 11) | 20) & 0xFu; }
#define XB_SPIN(cond, bar) do { unsigned _sp = 0; while (cond) { __builtin_amdgcn_s_sleep(1); \
    if ((++_sp & 255u) == 0u) { if (xb_ld(&(bar)[XB_TMO])) break; if (_sp > XB_SPIN_CAP) { atomicAdd(&(bar)[XB_TMO], 1u); break; } } } } while (0)

struct XcdBarrier {
    unsigned* bar; unsigned x;
    volatile LAS unsigned* st;
};

__device__ __forceinline__ XcdBarrier xcd_barrier_post(unsigned* bar, volatile LAS unsigned* st) {
    XcdBarrier b; b.bar = bar; b.x = xb_xcc_id(); b.st = st;
    if (threadIdx.x == 0) (void)xb_add(&bar[XB_XCNT(b.x)], 1u);
    return b;
}
__device__ __forceinline__ void xcd_barrier_complete(unsigned* bar, unsigned x, unsigned& nloc, unsigned& nx) {
    const unsigned G = gridDim.x * gridDim.y * gridDim.z;
    unsigned sum, cnt, mine, sp = 0u;
    for (;;) {
        sum = 0u; cnt = 0u; mine = 0u;
#pragma unroll
        for (unsigned j = 0; j < 16; ++j) { const unsigned c = xb_ld(&bar[XB_XCNT(j)]); sum += c; cnt += (c > 0u) ? 1u : 0u; mine = (j == x) ? c : mine; }
        if (sum == G) break;
        __builtin_amdgcn_s_sleep(1);
        if ((++sp & 255u) == 0u) { if (xb_ld(&bar[XB_TMO])) break; if (sp > XB_SPIN_CAP) { atomicAdd(&bar[XB_TMO], 1u); break; } }
    }
    nloc = mine > 0u ? mine : 1u; nx = cnt > 0u ? cnt : 1u;
}

__device__ __forceinline__ void xcd_barrier(const XcdBarrier& b) {
    asm volatile("s_waitcnt vmcnt(0)" ::: "memory");
    __syncthreads();
    if (threadIdx.x == 0) {
        unsigned* bar = b.bar;
        __builtin_amdgcn_s_waitcnt(0);
        unsigned nloc = b.st[0], nx = b.st[1];
        if (nloc == 0u) { xcd_barrier_complete(bar, b.x, nloc, nx); b.st[0] = nloc; b.st[1] = nx; }
        const unsigned old = xb_add(&bar[XB_XSUB(b.x)], 1u);
        const unsigned gen = old / nloc;
        if (old + 1u == (gen + 1u) * nloc) {
            __builtin_amdgcn_fence(__ATOMIC_RELEASE, "agent");
            asm volatile("s_waitcnt vmcnt(0)" ::: "memory");
            const unsigned og = xb_add(&bar[XB_TOP], 1u);
            const unsigned tg = og / nx;
            if (og + 1u == (tg + 1u) * nx) xb_add(&bar[XB_TOPGEN], 1u);
            else XB_SPIN(xb_ld(&bar[XB_TOPGEN]) == tg, bar);
            __builtin_amdgcn_fence(__ATOMIC_ACQUIRE, "agent");
            xb_add(&bar[XB_XGEN(b.x)], 1u);
            asm volatile("s_waitcnt vmcnt(0)" ::: "memory");
        } else {
            XB_SPIN(xb_ld(&bar[XB_XGEN(b.x)]) == gen, bar);
            __builtin_amdgcn_fence(__ATOMIC_ACQUIRE, "agent");
            asm volatile("s_waitcnt vmcnt(0)" ::: "memory");
        }
    }
    __syncthreads();
}

#ifndef RP_GU
#define RP_GU 1
#endif
#ifndef RP_INA
#define RP_INA 1
#endif
#ifndef RP_PREP
#define RP_PREP 1
#endif
#ifndef RP_SCAN
#define RP_SCAN 1
#endif
#ifndef RP_ATTN
#define RP_ATTN 1
#endif
#ifndef RP_MEM
#define RP_MEM 1
#endif
#ifndef RP_CONV
#define RP_CONV 1
#endif
#ifndef RP_UQ
#define RP_UQ 1
#endif
#ifndef RP_OUTROWS
#define RP_OUTROWS 1
#endif
#ifndef RP_P0
#define RP_P0 1
#endif
#ifndef REP_MEM
#define REP_MEM 1
#endif
#ifndef REP_ROWS
#define REP_ROWS 1
#endif
#ifndef REP_RES
#define REP_RES 1
#endif
#ifndef REP_INPROJ
#define REP_INPROJ 1
#endif
#ifndef REP_CONV
#define REP_CONV 1
#endif
#ifndef REP_GU
#define REP_GU 1
#endif
#ifndef REP_ATTN
#define REP_ATTN 1
#endif
#ifndef REP_SCAN
#define REP_SCAN 1
#endif
#ifndef REP_SYNC
#define REP_SYNC 1
#endif
#ifndef REP_PREP
#define REP_PREP 1
#endif
#define PHASE_IDS int tid_o_ = threadIdx.x; asm volatile("" : "+v"(tid_o_)); const int tid = tid_o_, lane = tid & 63, wid = __builtin_amdgcn_readfirstlane(tid >> 6), gw = bx * NW + wid; (void)lane; (void)gw; (void)tid
#define GSYNC_CG() do { asm volatile("s_waitcnt vmcnt(0) lgkmcnt(0)" ::: "memory"); grid.sync(); } while (0)
#define GSYNC() do { for (int r_ = 0; r_ < REP_SYNC; ++r_) xcd_barrier(xbar); } while (0)
#define CONV_UPPER(l_, grp_) do { if (2 * bx >= G) conv_group((const float* const*)(ws_ + WS_TAB), ws_, (l_), (grp_), L, (bx - G / 2) * NW + wid, (G - G / 2) * NW, lane, wid); __syncthreads();   } while (0)
#define SSQ(k) (WSP(float, WS_SSQ) + (size_t)(k) * S_ * 16)
#define WSP(T, off) ((T*)(ws_ + (off)))
#define INP(k) gptr(((const float* const*)(ws_ + WS_TAB)) + (k))
#define PHASE_BEGIN GAS unsigned char* wsg_ = (GAS unsigned char*)p.ws; int bx = blockIdx.x; asm volatile("" : "+s"(wsg_), "+s"(bx)); unsigned char* ws_ = (unsigned char*)wsg_; PHASE_IDS
__global__ void __launch_bounds__(NTHREADS, 2) fwd_megakernel(Params p) {
    extern __shared__ __attribute__((aligned(16))) unsigned char lds_raw[];
    cg::grid_group grid = cg::this_grid();
    ldsp L = (ldsp)lds_raw;
    const int G = gridDim.x, ngw = G * NW;
    volatile LAS unsigned* xst = (volatile LAS unsigned*)(L + XB_LDS_OFF);
    if (threadIdx.x < 2) xst[threadIdx.x] = 0u;
    __syncthreads();
    const XcdBarrier xbar = xcd_barrier_post((unsigned*)(p.ws + WS_XBAR), xst);

    {
        PHASE_BEGIN;
        if (tid == 0) {
            const float** T = (const float**)(ws_ + WS_TAB);
#pragma unroll
            for (int k = 0; k < 26; ++k) T[k] = p.in[k];
            float* TF = (float*)(ws_ + WS_TAB + 512);
#pragma unroll
            for (int k = 0; k < 32; ++k) TF[k] = p.invf[k];
        }
        asm volatile("s_waitcnt vmcnt(0)" ::: "memory");
        __syncthreads();
        __builtin_amdgcn_fence(__ATOMIC_ACQUIRE, "agent");
        const float* const* tin = (const float* const*)(ws_ + WS_TAB);
        LAS float* scr = (LAS float*)(L + wid * 16384);
        conv_group(tin, ws_, 0, 0, L, gw, ngw, lane, wid);
        conv_job(INP(22), D_, 320, 512, 0, WSP(bf16_t, WS_DKVT), scr, gw, ngw, lane, INP(21));
        conv_job(INP(24), 256, 1536, 768, 4, WSP(bf16_t, WS_UKT), scr, gw, ngw, lane);
        conv_job(INP(24), 256, 1536, 768, 5, WSP(bf16_t, WS_UVT), scr, gw, ngw, lane);
        norm_rows(INP(1), INP(11), WSP(bf16_t, WS_MEMN), 256, gw, ngw, lane);
        {
            const float* xin = INP(0); bf16_t* XB = WSP(bf16_t, WS_XN); float* sq0 = SSQ(12);
            for (int m = gw; m < S_; m += ngw) {
                float s = 0.f;
#pragma unroll
                for (int j = 0; j < 4; ++j) { const f32x4 v = *(const f32x4*)(xin + (size_t)m * D_ + 4 * lane + 256 * j);
                    u32x2 w; w.x = pk2(v[0], v[1]); w.y = pk2(v[2], v[3]); *(u32x2*)(XB + (size_t)m * D_ + 4 * lane + 256 * j) = w;
                    const float y0 = bflo(w.x), y1 = bfhi(w.x), y2 = bflo(w.y), y3 = bfhi(w.y); s += (y0 * y0 + y1 * y1) + (y2 * y2 + y3 * y3); }
                s = wave_sum(s);
                if (lane < 16) sq0[(size_t)m * 16 + lane] = lane == 0 ? s : 0.f;
            }
        }
        const int* positions = (const int*)INP(2);
        float2* ROPE = WSP(float2, WS_ROPE);
        for (int i = bx * NTHREADS + tid; i < S_ * 32; i += G * NTHREADS) {
            const int row = i >> 5, j = i & 31;
            const double a = (double)positions[row] * (double)((const float*)(ws_ + WS_TAB + 512))[j];
            const double rev = a * 0.15915494309189535; const float f = (float)(rev - rint(rev));
            ROPE[i] = make_float2(__builtin_amdgcn_cosf(f), __builtin_amdgcn_sinf(f));
        }
    }
    GSYNC_CG();

    for (int l = 0; l < 4; ++l) {
        const bool isA = l < 2;
        for (int rp_ = 0; rp_ < RP_GU; ++rp_) { PHASE_BEGIN; EpiSwiglu E{WSP(bf16_t, WS_H), l == 0 ? SSQ(12) : SSQ(3 * (l - 1) + 2)}; run_gemm(L, WSP(bf16_t, WS_XN), WSP(bf16_t, WS_W) + WO_GU1, S_, NGU, D_, bx, E); CONV_UPPER(l, 1); }
        {
            PHASE_BEGIN;
            EpiStore<true> Ek{WSP(bf16_t, WS_MEMK), 256, nullptr}; run_gemm(L, WSP(bf16_t, WS_MEMN), WSP(bf16_t, WS_W) + WO_MKV, 256, 256, D_, (bx + 1) % G, Ek);
            EpiStore<false> Ev{WSP(bf16_t, WS_MEMVT), 256, nullptr}; run_gemm(L, WSP(bf16_t, WS_W) + WO_MKV + (size_t)256 * D_, WSP(bf16_t, WS_MEMN), 256, 256, D_, (bx + 2) % G, Ev);
        }
        GSYNC();
        { PHASE_BEGIN; EpiResid E{WSP(bf16_t, WS_XN), 0.5f, SSQ(3 * l)}; run_gemm(L, WSP(bf16_t, WS_H), WSP(bf16_t, WS_W) + WO_D1, S_, D_, DFF, bx, E); }
        GSYNC();
        if (isA) {
            for (int rp_ = 0; rp_ < RP_INA; ++rp_) { PHASE_BEGIN; EpiStore<true> E{WSP(bf16_t, WS_HA), LDHA, SSQ(3 * l)}; run_gemm(L, WSP(bf16_t, WS_XN), WSP(bf16_t, WS_W) + WO_IN, S_, LDHA, D_, bx, E); CONV_UPPER(l, 2); }
            GSYNC();
            {
                PHASE_BEGIN;
                const float* convw = INP(14) + (size_t)l * 4 * 2304;
                for (int rp_ = 0; rp_ < RP_PREP; ++rp_) for (int u = bx; u < 1536; u += G) {
                    const int h = u % 6;
                    gdn_prep_unit(L, u, WSP(bf16_t, WS_HA), convw, __expf(INP(15)[l * 6 + h]), INP(16)[l * 6 + h],
                                  WSP(bf16_t, WS_NEGW), WSP(bf16_t, WS_QD), WSP(bf16_t, WS_KDT), WSP(bf16_t, WS_QK), WSP(bf16_t, WS_UT), WSP(float, WS_DCH), tid, wid, lane);
                }
            }
            for (int rp_ = 0; rp_ < RP_MEM; ++rp_) { PHASE_BEGIN; mem_attn(L, WSP(bf16_t, WS_HA), LDHA, QMA, WSP(bf16_t, WS_MEMK), WSP(bf16_t, WS_MEMVT), WSP(bf16_t, WS_MIX), tid, wid, lane); }
            GSYNC();
            for (int rp_ = 0; rp_ < RP_SCAN; ++rp_) if (blockIdx.x < 24) { PHASE_BEGIN; gdn_scan(L, bx >> 2, bx & 3, WSP(bf16_t, WS_NEGW), WSP(bf16_t, WS_QD), WSP(bf16_t, WS_KDT), WSP(bf16_t, WS_QK),
                                  WSP(bf16_t, WS_UT), WSP(float, WS_DCH), WSP(bf16_t, WS_HA), tid, wid, lane); }
            GSYNC();
            for (int rp_ = 0; rp_ < RP_OUTROWS; ++rp_) { PHASE_BEGIN; gdn_out_rows(WSP(bf16_t, WS_HA), INP(17) + l * 128, WSP(bf16_t, WS_MIX), gw, ngw, lane); }
            GSYNC();
        } else {
            { PHASE_BEGIN; EpiInB E{WSP(bf16_t, WS_HB), WSP(bf16_t, WS_CQN), SSQ(3 * l), WSP(float, WS_SQQ)}; run_gemm(L, WSP(bf16_t, WS_XN), WSP(bf16_t, WS_W) + WO_IN, S_, LDHB, D_, bx, E); CONV_UPPER(l, 2); }
            GSYNC();
            for (int rp_ = 0; rp_ < RP_UQ; ++rp_) { PHASE_BEGIN; EpiQ E{WSP(bf16_t, WS_QCAT), WSP(float2, WS_ROPE), 0.07216878364870323f * 1.4426950408889634f, WSP(float, WS_SQQ)}; run_gemm(L, WSP(bf16_t, WS_CQN), WSP(bf16_t, WS_W) + WO_UQ, S_, 1280, 256, bx, E); }
            GSYNC();
            for (int rp_ = 0; rp_ < RP_MEM; ++rp_) { PHASE_BEGIN; mem_attn(L, WSP(bf16_t, WS_HB), LDHB, QMB, WSP(bf16_t, WS_MEMK), WSP(bf16_t, WS_MEMVT), WSP(bf16_t, WS_MIX), tid, wid, lane); }
            for (int rp_ = 0; rp_ < RP_ATTN; ++rp_) { PHASE_BEGIN; mla_attn(L, WSP(bf16_t, WS_QCAT), WSP(bf16_t, WS_KCAT), WSP(bf16_t, WS_VT), WSP(bf16_t, WS_MIX), WSP(unsigned, WS_CTL) + 64 * (l - 2) + 128 * rp_, tid, wid, lane); __syncthreads(); }
            GSYNC();
        }
        { PHASE_BEGIN; EpiResid E{WSP(bf16_t, WS_XN), 1.0f, SSQ(3 * l + 1)}; run_gemm(L, WSP(bf16_t, WS_MIX), WSP(bf16_t, WS_W) + WO_OUT, S_, D_, D_, bx, E); }
        GSYNC();
        for (int rp_ = 0; rp_ < RP_GU; ++rp_) { PHASE_BEGIN; EpiSwiglu E{WSP(bf16_t, WS_H), SSQ(3 * l + 1)}; run_gemm(L, WSP(bf16_t, WS_XN), WSP(bf16_t, WS_W) + WO_GU2, S_, NGU, D_, bx, E); if (l < 3) CONV_UPPER(l + 1, 0); }
        GSYNC();
        { PHASE_BEGIN; EpiResid E{WSP(bf16_t, WS_XN), 0.5f, SSQ(3 * l + 2)}; run_gemm(L, WSP(bf16_t, WS_H), WSP(bf16_t, WS_W) + WO_D2, S_, D_, DFF, bx, E); }
        GSYNC();
        if (l == 1) {
            { PHASE_BEGIN; EpiStore<true> E{WSP(bf16_t, WS_HB), 512, SSQ(5)}; run_gemm(L, WSP(bf16_t, WS_XN), WSP(bf16_t, WS_DKVT), S_, 512, D_, bx, E); }
            GSYNC();
            {
                PHASE_BEGIN;
                const bf16_t* CKR = WSP(bf16_t, WS_HB); bf16_t* CKVN = WSP(bf16_t, WS_CQN); bf16_t* KCAT = WSP(bf16_t, WS_KCAT); const float2* ROPE = WSP(float2, WS_ROPE);
                const f32x4 gg = *(const f32x4*)(INP(23) + 4 * lane);
                for (int m = gw; m < S_; m += ngw) {
                    const bf16_t* rp = CKR + (size_t)m * 512;
                    const u32x2 v = *(const u32x2*)(rp + 4 * lane);
                    const float a0 = bflo(v.x), a1 = bfhi(v.x), a2 = bflo(v.y), a3 = bfhi(v.y);
                    const float r = rsqrtf(wave_sum(a0 * a0 + a1 * a1 + a2 * a2 + a3 * a3) * (1.f / 256.f) + EPS);
                    u32x2 w; w.x = pk2(a0 * r * gg[0], a1 * r * gg[1]); w.y = pk2(a2 * r * gg[2], a3 * r * gg[3]);
                    *(u32x2*)(CKVN + (size_t)m * 256 + 4 * lane) = w;
                    if (lane < 32) {
                        const float x1 = bf2f(rp[256 + lane]), x2 = bf2f(rp[288 + lane]);
                        const float2 cs = ROPE[(size_t)m * 32 + lane];
                        const unsigned o = pk2(x1 * cs.x - x2 * cs.y, x1 * cs.y + x2 * cs.x);
#pragma unroll
                        for (int h = 0; h < 6; ++h) { bf16_t* kp = KCAT + ((size_t)h * S_ + m) * 192 + 128 + lane; kp[0] = (bf16_t)(o & 0xffffu); kp[32] = (bf16_t)(o >> 16); }
                    }
                }
            }
            GSYNC();
            { PHASE_BEGIN; EpiKnope E{WSP(bf16_t, WS_KCAT)}; run_gemm(L, WSP(bf16_t, WS_CQN), WSP(bf16_t, WS_UKT), S_, 768, 256, bx, E); }
            { PHASE_BEGIN; EpiStore<false> E{WSP(bf16_t, WS_VT), S_, nullptr}; run_gemm(L, WSP(bf16_t, WS_UVT), WSP(bf16_t, WS_CQN), 768, S_, 256, bx, E); }
            GSYNC();
        }
    }
    {
        PHASE_BEGIN;
        const float* g = INP(25); const bf16_t* XB = WSP(bf16_t, WS_XN);
        for (int m = gw; m < S_; m += ngw) {
            float* orow = p.out + (size_t)m * D_;
            f32x4 v[4]; float s = 0.f;
#pragma unroll
            for (int j = 0; j < 4; ++j) { const u32x2 w = *(const u32x2*)(XB + (size_t)m * D_ + 4 * lane + 256 * j);
                v[j] = (f32x4){bflo(w.x), bfhi(w.x), bflo(w.y), bfhi(w.y)}; s += (v[j][0] * v[j][0] + v[j][1] * v[j][1]) + (v[j][2] * v[j][2] + v[j][3] * v[j][3]); }
            const float r = rsqrtf(wave_sum(s) * (1.f / D_) + EPS);
#pragma unroll
            for (int j = 0; j < 4; ++j) { const f32x4 gg = *(const f32x4*)(g + 4 * lane + 256 * j); *(f32x4*)(orow + 4 * lane + 256 * j) = v[j] * r * gg; }
        }
    }
}

extern "C" void kernel_launch(void* const* d_in, const int* in_sizes, int n_in, void* d_out, int out_size, void* d_ws, size_t ws_size, hipStream_t stream) {
    static int grid_blocks = 0;
    if (grid_blocks == 0) {
        int dev = 0, cus = 0, per_cu = 0;
        hipGetDevice(&dev);
        hipDeviceGetAttribute(&cus, hipDeviceAttributeMultiprocessorCount, dev);
        hipFuncSetAttribute((const void*)fwd_megakernel, hipFuncAttributeMaxDynamicSharedMemorySize, LDS_BYTES);
        hipOccupancyMaxActiveBlocksPerMultiprocessor(&per_cu, (const void*)fwd_megakernel, NTHREADS, LDS_BYTES);
        if (per_cu < 1) per_cu = 1;
        grid_blocks = cus * per_cu;
        if (ws_size < WS_END) fprintf(stderr, "kernel_launch: workspace too small: %zu < %zu\n", ws_size, (size_t)WS_END);
    }
    (void)hipMemsetAsync((char*)d_ws + WS_CTL, 0, CTL_ZERO_BYTES, stream);
    Params p{};
    for (int i = 0; i < 26; ++i) p.in[i] = (const float*)d_in[i];
    p.out = (float*)d_out; p.ws = (unsigned char*)d_ws;
    for (int j = 0; j < 32; ++j) p.invf[j] = (float)pow(10000.0, -(double)(2 * j) / 64.0);
    void* args[] = {&p};
    hipError_t e = hipLaunchCooperativeKernel((const void*)fwd_megakernel, dim3(grid_blocks), dim3(NTHREADS), args, LDS_BYTES, stream);
    if (e != hipSuccess) fprintf(stderr, "cooperative launch failed: %s (grid %d)\n", hipGetErrorString(e), grid_blocks);
}
```

```cpp
#include <hip/hip_runtime.h>
#include <hip/hip_cooperative_groups.h>
#include <cstdio>
#include <cstdint>
#include <cmath>
namespace cg = cooperative_groups;
namespace pg8 {
#define PG8_LAS __attribute__((address_space(3)))
typedef unsigned short bf16_t;
typedef short bf16x8 __attribute__((ext_vector_type(8)));
typedef float f32x4 __attribute__((ext_vector_type(4)));
typedef unsigned u32x4 __attribute__((ext_vector_type(4)));
constexpr int BM = 256, BK = 64, HALF = 128, HTB = HALF * BK * 2  , STAGE_BYTES = 8 * HTB, NXCD = 8, WGM = 8;

__host__ __device__ __forceinline__ int lds_byte(int r, int c) { const int st = (r >> 4) * 2 + (c >> 5), rr = r & 15, cc = c & 31, ob = rr * 64 + cc * 2; return st * 1024 + (ob ^ (((ob >> 9) & 1) << 5)); }
__host__ __device__ __forceinline__ void stage_rc(int b, int& R, int& C) { const int st = b / 1024, sb = b % 1024, swz = sb ^ (((sb >> 9) & 1) << 5); R = (st >> 1) * 16 + swz / 64; C = (st & 1) * 32 + (swz % 64) / 2; }
__host__ __device__ __forceinline__ int perm32(int rho) { const int n = rho >> 4, i = rho & 15; return 8 * (i >> 2) + 4 * n + (i & 3); }

struct Unit { int pm, pn; };
struct Gemm { const bf16_t* A; const bf16_t* Bt; int M, N, K; };

struct StaticOrder {
    int nM, nN, nwg, G, c;
    __host__ __device__ void init(int M, int N, int G_, int c_) { nM = M / BM; nN = N / BM; nwg = nM * nN; G = G_; c = c_; }
    __host__ __device__ bool next(int i, Unit& u) const {
        const long L = (long)i * G + c; if (L >= nwg) return false;
        int wgid = (int)L; { const int q = nwg / NXCD, r = nwg % NXCD, xcd = wgid % NXCD, off = wgid / NXCD; wgid = (xcd < r ? xcd * (q + 1) : r * (q + 1) + (xcd - r) * q) + off; }
        const int nig = WGM * nN, gid = wgid / nig, fm = gid * WGM, gsz = (nM - fm) < WGM ? (nM - fm) : WGM;
        u.pm = fm + ((wgid % nig) % gsz); u.pn = (wgid % nig) / gsz; return true;
    }
    __device__ __forceinline__ void a_ready(const Unit&) const {}
    __device__ __forceinline__ void done(const Unit&) const {}
};

__device__ __forceinline__ unsigned cvt_pk_bf16(float lo, float hi) { unsigned r; asm volatile("v_cvt_pk_bf16_f32 %0, %1, %2" : "=v"(r) : "v"(lo), "v"(hi)); return r; }
typedef float f32x2 __attribute__((ext_vector_type(2)));
template <class Epi, class Sched, bool ALIGN_EPI = false, bool SP2 = false>
__device__ __forceinline__ void gemm_phase(PG8_LAS unsigned char* lds, const Gemm g, const Sched& S, const Epi& E) {
    int tid_o = threadIdx.x; asm volatile("" : "+v"(tid_o)); const int tid = tid_o, wid = __builtin_amdgcn_readfirstlane(tid >> 6), lane = tid & 63, wr = wid >> 2, wc = wid & 3, fr = lane & 15, fq = lane >> 4;
    const int K = g.K, nt = K / BK;
    unsigned voffA[2], voffB[2];
#pragma unroll
    for (int i = 0; i < 2; ++i) { int R, C; stage_rc(tid * 16 + i * 8192, R, C); const int Rb = Epi::PERM ? ((R & ~31) + perm32(R & 31)) : R;
        voffA[i] = (unsigned)(R * K + C) * 2u; voffB[i] = (unsigned)(Rb * K + C) * 2u; }
    const size_t kstep = (size_t)(BK * 2);
    const size_t hstep = (size_t)HALF * K * 2;
    const size_t tstep = 2 * hstep;
    const unsigned ldsw = (unsigned)wid * 1024u;
    const int aoff = lds_byte(wr * 64 + fr, fq * 8), boff = lds_byte(wc * 32 + fr, fq * 8);
#define PG8_SA(b, h) (((b) * 2 + (h)) * HTB)
#define PG8_SB(b, h) ((4 + (b) * 2 + (h)) * HTB)
#define PG8_STAGE(bufoff, gbase, voff) do { _Pragma("unroll") for (int _i = 0; _i < 2; ++_i) \
        __builtin_amdgcn_global_load_lds((const unsigned*)((const char*)(gbase) + (voff)[_i]), (PG8_LAS unsigned*)(lds + (bufoff) + ldsw + _i * 8192), 16, 0, 0); } while (0)
#define PG8_LDA(dst, b, h) do { _Pragma("unroll") for (int m = 0; m < 4; ++m) _Pragma("unroll") for (int k = 0; k < 2; ++k) dst[m][k] = *(const PG8_LAS bf16x8*)(lds + PG8_SA(b, h) + aoff + m * 2048 + k * 1024); } while (0)
#define PG8_LDB(dst, b, h) do { _Pragma("unroll") for (int n = 0; n < 2; ++n) _Pragma("unroll") for (int k = 0; k < 2; ++k) dst[n][k] = *(const PG8_LAS bf16x8*)(lds + PG8_SB(b, h) + boff + n * 2048 + k * 1024); } while (0)
#define PG8_MMA(ai, bj, At, Bt) do { __builtin_amdgcn_s_setprio(1); _Pragma("unroll") for (int m = 0; m < 4; ++m) _Pragma("unroll") for (int n = 0; n < 2; ++n) _Pragma("unroll") for (int k = 0; k < 2; ++k) \
        acc[ai][bj][m][n] = __builtin_amdgcn_mfma_f32_16x16x32_bf16(Bt[n][k], At[m][k], acc[ai][bj][m][n], 0, 0, 0); __builtin_amdgcn_s_setprio(0); } while (0)
#define PG8_WAIT_V(n) asm volatile("s_waitcnt vmcnt(" #n ")" ::: "memory")
#define PG8_WAIT_L(n) asm volatile("s_waitcnt lgkmcnt(" #n ")" ::: "memory")
#define PG8_BAR __builtin_amdgcn_s_barrier()
#define PG8_SCHED __builtin_amdgcn_sched_barrier(0)
    Unit cur, nxt; int ui = 0;
    if (!S.next(0, cur)) return;
    f32x4 acc[2][2][4][2];
#pragma unroll
    for (int a = 0; a < 2; ++a)
#pragma unroll
        for (int b = 0; b < 2; ++b)
#pragma unroll
            for (int m = 0; m < 4; ++m)
#pragma unroll
                for (int n = 0; n < 2; ++n) acc[a][b][m][n] = (f32x4){0.f, 0.f, 0.f, 0.f};
    bf16x8 At[4][2], B0[2][2], B1[2][2];
    const char* cA = (const char*)g.A + (size_t)cur.pm * tstep; const char* cB = (const char*)g.Bt + (size_t)cur.pn * tstep;
    S.a_ready(cur);
    if constexpr (SP2) {
        PG8_STAGE(PG8_SB(0, 0), cB, voffB); PG8_STAGE(PG8_SB(0, 1), cB + hstep, voffB); PG8_STAGE(PG8_SA(0, 0), cA, voffA); PG8_STAGE(PG8_SA(0, 1), cA + hstep, voffA);
        if (wr == 1) PG8_BAR;
        PG8_WAIT_V(2); PG8_BAR;
        PG8_STAGE(PG8_SB(1, 0), cB + kstep, voffB); PG8_STAGE(PG8_SA(1, 0), cA + kstep, voffA); PG8_STAGE(PG8_SB(1, 1), cB + hstep + kstep, voffB);
        PG8_WAIT_V(6); PG8_BAR;
    } else {
        PG8_STAGE(PG8_SB(0, 0), cB, voffB); PG8_STAGE(PG8_SA(0, 0), cA, voffA); PG8_STAGE(PG8_SB(0, 1), cB + hstep, voffB); PG8_STAGE(PG8_SA(0, 1), cA + hstep, voffA);
        if (wr == 1) PG8_BAR;
        PG8_WAIT_V(4); PG8_BAR;
        PG8_STAGE(PG8_SB(1, 0), cB + kstep, voffB); PG8_STAGE(PG8_SA(1, 0), cA + kstep, voffA); PG8_STAGE(PG8_SB(1, 1), cB + hstep + kstep, voffB);
        PG8_WAIT_V(6); PG8_BAR;
    }
    for (;;) {
        const bool has_next = S.next(ui + 1, nxt);
        const char* nA = has_next ? (const char*)g.A + (size_t)nxt.pm * tstep : cA; const char* nB = has_next ? (const char*)g.Bt + (size_t)nxt.pn * tstep : cB;
        for (int t = 0; t < nt; t += 2) {
            const bool last = (t == nt - 2);
            const char* a1 = cA + (size_t)(t + 1) * kstep;
            const char* a2 = last ? nA : cA + (size_t)(t + 2) * kstep; const char* b2 = last ? nB : cB + (size_t)(t + 2) * kstep;
            const char* a3 = a2 + kstep; const char* b3 = b2 + kstep;
            if (last && has_next) S.a_ready(nxt);
            if constexpr (SP2) {
            PG8_LDB(B0, 0, 0); PG8_LDB(B1, 0, 1); PG8_SCHED; PG8_LDA(At, 0, 0); PG8_STAGE(PG8_SA(1, 1), a1 + hstep, voffA);
            PG8_WAIT_V(8); PG8_WAIT_L(0); PG8_BAR; PG8_MMA(0, 0, At, B0); PG8_MMA(0, 1, At, B1); PG8_BAR; PG8_SCHED;
            PG8_LDA(At, 0, 1); PG8_STAGE(PG8_SB(0, 0), b2, voffB); PG8_STAGE(PG8_SB(0, 1), b2 + hstep, voffB); PG8_STAGE(PG8_SA(0, 0), a2, voffA);
            PG8_WAIT_V(8); PG8_WAIT_L(0); PG8_BAR; PG8_MMA(1, 0, At, B0); PG8_MMA(1, 1, At, B1); PG8_BAR; PG8_SCHED;
            PG8_LDB(B0, 1, 0); PG8_LDB(B1, 1, 1); PG8_SCHED; PG8_LDA(At, 1, 0); PG8_STAGE(PG8_SA(0, 1), a2 + hstep, voffA);
            PG8_WAIT_V(8); PG8_WAIT_L(0); PG8_BAR; PG8_MMA(0, 0, At, B0); PG8_MMA(0, 1, At, B1); PG8_BAR; PG8_SCHED;
            PG8_LDA(At, 1, 1); PG8_STAGE(PG8_SB(1, 0), b3, voffB); PG8_STAGE(PG8_SB(1, 1), b3 + hstep, voffB); PG8_STAGE(PG8_SA(1, 0), a3, voffA);
            PG8_WAIT_V(8); PG8_WAIT_L(0); PG8_BAR; PG8_MMA(1, 0, At, B0); PG8_MMA(1, 1, At, B1); PG8_BAR; PG8_SCHED;
            } else {
            PG8_LDB(B0, 0, 0); PG8_SCHED; PG8_LDA(At, 0, 0); PG8_STAGE(PG8_SA(1, 1), a1 + hstep, voffA);
            PG8_WAIT_L(8); PG8_BAR; PG8_WAIT_L(0); PG8_MMA(0, 0, At, B0); PG8_BAR; PG8_SCHED;
            PG8_LDB(B1, 0, 1); PG8_STAGE(PG8_SB(0, 0), b2, voffB);
            PG8_BAR; PG8_WAIT_L(0); PG8_MMA(0, 1, At, B1); PG8_BAR;
            PG8_LDA(At, 0, 1); PG8_STAGE(PG8_SA(0, 0), a2, voffA);
            PG8_BAR; PG8_WAIT_L(0); PG8_MMA(1, 0, At, B0); PG8_BAR; PG8_SCHED;
            PG8_STAGE(PG8_SB(0, 1), b2 + hstep, voffB);
            PG8_WAIT_V(6); PG8_BAR; PG8_MMA(1, 1, At, B1); PG8_BAR;
            PG8_LDB(B0, 1, 0); PG8_SCHED; PG8_LDA(At, 1, 0); PG8_STAGE(PG8_SA(0, 1), a2 + hstep, voffA);
            PG8_WAIT_L(8); PG8_BAR; PG8_WAIT_L(0); PG8_MMA(0, 0, At, B0); PG8_BAR; PG8_SCHED;
            PG8_LDB(B1, 1, 1); PG8_STAGE(PG8_SB(1, 0), b3, voffB);
            PG8_BAR; PG8_WAIT_L(0); PG8_MMA(0, 1, At, B1); PG8_BAR;
            PG8_LDA(At, 1, 1); PG8_STAGE(PG8_SA(1, 0), a3, voffA);
            PG8_BAR; PG8_WAIT_L(0); PG8_MMA(1, 0, At, B0); PG8_BAR; PG8_SCHED;
            PG8_STAGE(PG8_SB(1, 1), b3 + hstep, voffB);
            PG8_WAIT_V(6); PG8_BAR; PG8_MMA(1, 1, At, B1); PG8_BAR;
            }
        }
        if constexpr (ALIGN_EPI) { if (wr == 0) PG8_BAR; }
        if constexpr (!Epi::AFTER_DRAIN) { E(acc, cur, wr, wc, fr, fq); S.done(cur); }
        if (!has_next) break;
#pragma unroll
        for (int a = 0; a < 2; ++a)
#pragma unroll
            for (int b = 0; b < 2; ++b)
#pragma unroll
                for (int m = 0; m < 4; ++m)
#pragma unroll
                    for (int n = 0; n < 2; ++n) acc[a][b][m][n] = (f32x4){0.f, 0.f, 0.f, 0.f};
        cur = nxt; cA = nA; cB = nB; ++ui;
        if constexpr (ALIGN_EPI) { if (wr == 1) PG8_BAR; }
    }
    PG8_WAIT_V(0);
    if constexpr (!ALIGN_EPI) { if (wr == 0) PG8_BAR; }
    PG8_BAR;
    if constexpr (Epi::AFTER_DRAIN) { E.fused(acc, cur, wr, wc, fr, fq, lds, wid, lane); S.done(cur); }
#undef PG8_SA
#undef PG8_SB
#undef PG8_STAGE
#undef PG8_LDA
#undef PG8_LDB
#undef PG8_MMA
#undef PG8_WAIT_V
#undef PG8_WAIT_L
#undef PG8_BAR
#undef PG8_SCHED
}
}

#define LAS __attribute__((address_space(3)))
using pg8::bf16_t; using pg8::bf16x8; using pg8::f32x4; using pg8::u32x4;
typedef unsigned u32x2 __attribute__((ext_vector_type(2)));
typedef LAS unsigned char* ldsp;

constexpr int S_ = 16384, D_ = 1024, DFF = 2816, NGU = 5632;
constexpr int LDHA = 3584, QMA = 3328, LDHB = 512, QMB = 256;
constexpr int NTHREADS = 512, NW = 8;
constexpr int LDS_BYTES = 147456, XB_LDS_OFF = 147200;
constexpr float EPS = 1e-6f;

constexpr size_t MiB = 1u << 20;
constexpr size_t WS_CTL = 0, WS_TAB = 2048, WS_XBAR = 16384, CTL_ZERO_BYTES = 32768, WS_ROPE = 1 * MiB, WS_MEMN = 5 * MiB, WS_MEMK = 5 * MiB + 512 * 1024, WS_MEMVT = 5 * MiB + 640 * 1024;
constexpr size_t WS_DKVT = 6 * MiB, WS_UKT = 7 * MiB, WS_UVT = 7 * MiB + 384 * 1024;
constexpr size_t WS_W = 8 * MiB, WS_X = 54 * MiB, WS_XN = 118 * MiB, WS_KCAT = 150 * MiB, WS_VT = 186 * MiB;
constexpr size_t WS_HA = 150 * MiB, WS_NEGW = 262 * MiB, WS_QD = 286 * MiB, WS_KDT = 310 * MiB, WS_QK = 334 * MiB, WS_UT = 346 * MiB, WS_DCH = 370 * MiB;
constexpr size_t WS_H = 210 * MiB, WS_HB = 210 * MiB, WS_CQN = 226 * MiB, WS_QCAT = 234 * MiB;
constexpr size_t WS_MIX = 54 * MiB;
constexpr size_t WS_XG2 = 298 * MiB;
constexpr size_t WS_SSQ = 371 * MiB;
constexpr size_t WS_SQQ = 384 * MiB;
constexpr size_t WS_END = 385 * MiB;
constexpr size_t WO_GU1 = 0, WO_D1 = 5767168, WO_GU2 = 8650752, WO_D2 = 14417920, WO_OUT = 17301504, WO_MKV = 18350080, WO_IN = 18874368, WO_UQ = 19398656;

#define GAS __attribute__((address_space(1)))
__device__ __forceinline__ const float* gptr(const float* const* slot) { const unsigned long long v = *(const unsigned long long*)slot; return (const float*)(GAS const float*)v; }
struct Params { const float* in[26]; float* out; unsigned char* ws; float invf[32]; };

typedef float f32x2_t __attribute__((ext_vector_type(2))); typedef __bf16 bf16x2_t __attribute__((ext_vector_type(2)));
__device__ __forceinline__ unsigned pk2(float lo, float hi) { f32x2_t v = {lo, hi}; bf16x2_t b = __builtin_convertvector(v, bf16x2_t); return __builtin_bit_cast(unsigned, b); }
__device__ __forceinline__ float bf2f(unsigned short b) { return __uint_as_float(((unsigned)b) << 16); }
__device__ __forceinline__ float bflo(unsigned w) { return __uint_as_float(w << 16); }
__device__ __forceinline__ float bfhi(unsigned w) { return __uint_as_float(w & 0xffff0000u); }
__device__ __forceinline__ float wave_sum(float v) {
#pragma unroll
    for (int o = 1; o < 64; o <<= 1) v += __shfl_xor(v, o);
    return v;
}
__device__ __forceinline__ f32x4 mma(bf16x8 x, bf16x8 y, f32x4 c) { return __builtin_amdgcn_mfma_f32_16x16x32_bf16(x, y, c, 0, 0, 0); }
__device__ __forceinline__ float silu_f(float v) { return v * __builtin_amdgcn_rcpf(1.f + __builtin_amdgcn_exp2f(v * -1.4426950408889634f)); }
__device__ __forceinline__ int swzA(int r, int ch) { return r * 256 + ((ch ^ (r & 15)) << 4); }
__device__ __forceinline__ int swzB(int r, int ch) { return r * 128 + ((ch ^ (r & 7)) << 4); }
__device__ __forceinline__ bf16x8 ldsfrag(ldsp p) { return *(LAS bf16x8*)p; }
__device__ __forceinline__ bf16x8 gfrag(const bf16_t* p) { return *(const bf16x8*)p; }
__device__ __forceinline__ bf16x8 pack8(f32x4 a, f32x4 b) { u32x4 w; w.x = pk2(a[0], a[1]); w.y = pk2(a[2], a[3]); w.z = pk2(b[0], b[1]); w.w = pk2(b[2], b[3]); return __builtin_bit_cast(bf16x8, w); }
__device__ __forceinline__ u32x2 pack4(f32x4 a) { u32x2 w; w.x = pk2(a[0], a[1]); w.y = pk2(a[2], a[3]); return w; }

__device__ __forceinline__ float row_rstd(const float* ssq, int row, int fq) {
    const f32x4 pv = *(const f32x4*)(ssq + (size_t)row * 16 + 4 * fq);
    float s = (pv[0] + pv[1]) + (pv[2] + pv[3]);
    s += __shfl_xor(s, 16); s += __shfl_xor(s, 32);
    return rsqrtf(s * (1.f / D_) + EPS);
}
__device__ __forceinline__ void row_rstd8(const float* ssq, int row0, int fq, float (&r8)[2][4]) {
    f32x4 pv[2][4];
#pragma unroll
    for (int ai = 0; ai < 2; ++ai)
#pragma unroll
        for (int m = 0; m < 4; ++m) pv[ai][m] = *(const f32x4*)(ssq + (size_t)(row0 + ai * 128 + m * 16) * 16 + 4 * fq);
#pragma unroll
    for (int ai = 0; ai < 2; ++ai)
#pragma unroll
        for (int m = 0; m < 4; ++m) { float s = (pv[ai][m][0] + pv[ai][m][1]) + (pv[ai][m][2] + pv[ai][m][3]);
            s += __shfl_xor(s, 16); s += __shfl_xor(s, 32); r8[ai][m] = rsqrtf(s * (1.f / D_) + EPS); }
}
struct EpiSwiglu {
    static constexpr bool PERM = true, AFTER_DRAIN = false; bf16_t* H; const float* ssq;
    __device__ __forceinline__ void operator()(const f32x4 (&acc)[2][2][4][2], const pg8::Unit& u, int wr, int wc, int fr, int fq) const {
        const int row0 = u.pm * 256 + wr * 64 + fr, col = u.pn * 128 + wc * 32 + 8 * fq;
        float r8[2][4]; row_rstd8(ssq, row0, fq, r8);
#pragma unroll
        for (int ai = 0; ai < 2; ++ai)
#pragma unroll
            for (int m = 0; m < 4; ++m) {
                const float r = r8[ai][m];
                const f32x4 g0 = acc[ai][0][m][0] * r, g1 = acc[ai][0][m][1] * r, u0 = acc[ai][1][m][0] * r, u1 = acc[ai][1][m][1] * r;
                u32x4 w;
                w.x = pk2(silu_f(g0[0]) * u0[0], silu_f(g0[1]) * u0[1]); w.y = pk2(silu_f(g0[2]) * u0[2], silu_f(g0[3]) * u0[3]);
                w.z = pk2(silu_f(g1[0]) * u1[0], silu_f(g1[1]) * u1[1]); w.w = pk2(silu_f(g1[2]) * u1[2], silu_f(g1[3]) * u1[3]);
                *(u32x4*)(H + (size_t)(row0 + ai * 128 + m * 16) * DFF + col) = w;
            }
    }
};
struct EpiResid {
    static constexpr bool PERM = false, AFTER_DRAIN = false; bf16_t* xb; float scale; float* ssq;
    __device__ __forceinline__ void operator()(const f32x4 (&acc)[2][2][4][2], const pg8::Unit& u, int wr, int wc, int fr, int fq) const {
        const int row0 = u.pm * 256 + wr * 64 + fr, col0 = u.pn * 256 + wc * 32 + 4 * fq;
#pragma unroll
        for (int ai = 0; ai < 2; ++ai)
#pragma unroll
            for (int m = 0; m < 4; ++m) {
                const int row = row0 + ai * 128 + m * 16;
                float sq = 0.f;
#pragma unroll
                for (int bj = 0; bj < 2; ++bj)
#pragma unroll
                    for (int n = 0; n < 2; ++n) {
                        const size_t off = (size_t)row * D_ + col0 + bj * 128 + n * 16;
                        const u32x2 b = *(const u32x2*)(xb + off);
                        const f32x4 a = acc[ai][bj][m][n];
                        u32x2 w; w.x = pk2(bflo(b.x) + a[0] * scale, bfhi(b.x) + a[1] * scale); w.y = pk2(bflo(b.y) + a[2] * scale, bfhi(b.y) + a[3] * scale);
                        *(u32x2*)(xb + off) = w;
                        const float y0 = bflo(w.x), y1 = bfhi(w.x), y2 = bflo(w.y), y3 = bfhi(w.y);
                        sq += (y0 * y0 + y1 * y1) + (y2 * y2 + y3 * y3);
                    }
                sq += __shfl_xor(sq, 16); sq += __shfl_xor(sq, 32);
                if (fq == 0) ssq[(size_t)row * 16 + u.pn * 4 + wc] = sq;
            }
    }
};
template <bool P> struct EpiStore {
    static constexpr bool PERM = P, AFTER_DRAIN = false; bf16_t* O; int ldc; const float* ssq;
    __device__ __forceinline__ void operator()(const f32x4 (&acc)[2][2][4][2], const pg8::Unit& u, int wr, int wc, int fr, int fq) const {
        const int row0 = u.pm * 256 + wr * 64 + fr, col0 = u.pn * 256 + wc * 32 + 8 * fq;
        float r8[2][4];
        if (ssq) row_rstd8(ssq, row0, fq, r8);
#pragma unroll
        for (int ai = 0; ai < 2; ++ai)
#pragma unroll
            for (int m = 0; m < 4; ++m) {
                const float r = ssq ? r8[ai][m] : 1.f;
#pragma unroll
                for (int bj = 0; bj < 2; ++bj) {
                    u32x4 w; const f32x4 a = acc[ai][bj][m][0] * r, b = acc[ai][bj][m][1] * r;
                    w.x = pk2(a[0], a[1]); w.y = pk2(a[2], a[3]); w.z = pk2(b[0], b[1]); w.w = pk2(b[2], b[3]);
                    *(u32x4*)(O + (size_t)(row0 + ai * 128 + m * 16) * ldc + col0 + bj * 128) = w;
                }
            }
    }
};
struct EpiInB {
    static constexpr bool PERM = true, AFTER_DRAIN = false; bf16_t* HB; bf16_t* CQ; const float* ssq; float* sqq;
    __device__ __forceinline__ void operator()(const f32x4 (&acc)[2][2][4][2], const pg8::Unit& u, int wr, int wc, int fr, int fq) const {
        const int row0 = u.pm * 256 + wr * 64 + fr, cw = wc * 32 + 8 * fq;
        float r8[2][4]; row_rstd8(ssq, row0, fq, r8);
#pragma unroll
        for (int ai = 0; ai < 2; ++ai)
#pragma unroll
            for (int m = 0; m < 4; ++m) {
                const int row = row0 + ai * 128 + m * 16;
                const float r = r8[ai][m];
                float sq = 0.f;
#pragma unroll
                for (int bj = 0; bj < 2; ++bj) {
                    u32x4 w; const f32x4 a = acc[ai][bj][m][0] * r, b = acc[ai][bj][m][1] * r;
                    w.x = pk2(a[0], a[1]); w.y = pk2(a[2], a[3]); w.z = pk2(b[0], b[1]); w.w = pk2(b[2], b[3]);
                    if (u.pn == 0) {
                        *(u32x4*)(CQ + (size_t)row * 256 + bj * 128 + cw) = w;
                        const float y0 = bflo(w.x), y1 = bfhi(w.x), y2 = bflo(w.y), y3 = bfhi(w.y), y4 = bflo(w.z), y5 = bfhi(w.z), y6 = bflo(w.w), y7 = bfhi(w.w);
                        sq += ((y0 * y0 + y1 * y1) + (y2 * y2 + y3 * y3)) + ((y4 * y4 + y5 * y5) + (y6 * y6 + y7 * y7));
                    } else *(u32x4*)(HB + (size_t)row * LDHB + 256 + bj * 128 + cw) = w;
                }
                if (u.pn == 0) { sq += __shfl_xor(sq, 16); sq += __shfl_xor(sq, 32); if (fq == 0) sqq[(size_t)row * 4 + wc] = sq; }
            }
    }
};
struct EpiKnope {
    static constexpr bool PERM = true, AFTER_DRAIN = false; bf16_t* K;
    __device__ __forceinline__ void operator()(const f32x4 (&acc)[2][2][4][2], const pg8::Unit& u, int wr, int wc, int fr, int fq) const {
        const int row0 = u.pm * 256 + wr * 64 + fr, d = wc * 32 + 8 * fq;
#pragma unroll
        for (int ai = 0; ai < 2; ++ai)
#pragma unroll
            for (int m = 0; m < 4; ++m)
#pragma unroll
                for (int bj = 0; bj < 2; ++bj) {
                    const int head = 2 * u.pn + bj;
                    u32x4 w; const f32x4 a = acc[ai][bj][m][0], b = acc[ai][bj][m][1];
                    w.x = pk2(a[0], a[1]); w.y = pk2(a[2], a[3]); w.z = pk2(b[0], b[1]); w.w = pk2(b[2], b[3]);
                    *(u32x4*)(K + ((size_t)head * S_ + row0 + ai * 128 + m * 16) * 192 + d) = w;
                }
    }
};
struct EpiQ {
    static constexpr bool PERM = true, AFTER_DRAIN = false; bf16_t* Q; const float2* tab; float qs; const float* sqq;
    __device__ __forceinline__ float rq(int row) const { const f32x4 s = *(const f32x4*)(sqq + (size_t)row * 4); return rsqrtf(((s[0] + s[1]) + (s[2] + s[3])) * (1.f / 256.f) + EPS) * qs; }
    __device__ __forceinline__ void operator()(const f32x4 (&acc)[2][2][4][2], const pg8::Unit& u, int wr, int wc, int fr, int fq) const {
        const int row0 = u.pm * 256 + wr * 64 + fr;
        if (u.pn < 3) {
            const int d = wc * 32 + 8 * fq;
#pragma unroll
            for (int ai = 0; ai < 2; ++ai)
#pragma unroll
                for (int m = 0; m < 4; ++m)
#pragma unroll
                    for (int bj = 0; bj < 2; ++bj) {
                        const int head = 2 * u.pn + bj;
                        u32x4 w; const f32x4 a = acc[ai][bj][m][0] * rq(row0 + ai * 128 + m * 16), b = acc[ai][bj][m][1] * rq(row0 + ai * 128 + m * 16);
                        w.x = pk2(a[0], a[1]); w.y = pk2(a[2], a[3]); w.z = pk2(b[0], b[1]); w.w = pk2(b[2], b[3]);
                        *(u32x4*)(Q + ((size_t)(row0 + ai * 128 + m * 16) * 6 + head) * 192 + d) = w;
                    }
        } else {
            const int head = 4 * (u.pn - 3) + wc;
            if (head < 6) {
#pragma unroll
                for (int ai = 0; ai < 2; ++ai)
#pragma unroll
                    for (int m = 0; m < 4; ++m) {
                        const int row = row0 + ai * 128 + m * 16;
                        float o1[8], o2[8]; const float qr = rq(row);
#pragma unroll
                        for (int n = 0; n < 2; ++n)
#pragma unroll
                            for (int j = 0; j < 4; ++j) {
                                const float2 cs = tab[(size_t)row * 32 + 8 * fq + 4 * n + j];
                                const float x1 = acc[ai][0][m][n][j], x2 = acc[ai][1][m][n][j];
                                o1[4 * n + j] = (x1 * cs.x - x2 * cs.y) * qr; o2[4 * n + j] = (x1 * cs.y + x2 * cs.x) * qr;
                            }
                        u32x4 w1, w2;
                        w1.x = pk2(o1[0], o1[1]); w1.y = pk2(o1[2], o1[3]); w1.z = pk2(o1[4], o1[5]); w1.w = pk2(o1[6], o1[7]);
                        w2.x = pk2(o2[0], o2[1]); w2.y = pk2(o2[2], o2[3]); w2.z = pk2(o2[4], o2[5]); w2.w = pk2(o2[6], o2[7]);
                        bf16_t* qp = Q + ((size_t)row * 6 + head) * 192 + 128 + 8 * fq;
                        *(u32x4*)qp = w1; *(u32x4*)(qp + 32) = w2;
                    }
            }
        }
    }
};

template <class Epi> __device__ __forceinline__ void run_gemm(ldsp lds, const bf16_t* A, const bf16_t* Bt, int M, int N, int K, int c, const Epi& E) {
    asm volatile("" : "+s"(M), "+s"(N), "+s"(K), "+s"(c));
    pg8::Gemm g{A, Bt, M, N, K}; pg8::StaticOrder S; S.init(M, N, (int)gridDim.x, c);
    pg8::gemm_phase<Epi, pg8::StaticOrder, true, true>(lds, g, S, E);
}

__device__ __forceinline__ int wmap(int map, int n, int nsrc) {
    switch (map) {
    case 0: return n < nsrc ? n : -1;
    case 1: { const int t = n >> 8, w = n & 255; return (w >> 7) * DFF + t * 128 + (w & 127); }
    case 2: { if (n < 768) return (n >> 7) * 192 + (n & 127);
              const int m = n - 768, t = m >> 8, w = m & 255, bj = w >> 7, cc = w & 127, head = 4 * t + (cc >> 5), jj = cc & 31;
              return head < 6 ? head * 192 + 128 + bj * 32 + jj : -1; }
    case 3: return n < 3084 ? n : (n >= QMA ? n - QMA + 3084 : -1);
    case 4: return (n >> 7) * 256 + (n & 127);
    default: return (n >> 7) * 256 + 128 + (n & 127);
    }
}
__device__ __forceinline__ void conv_job(const float* W, int K, int Nsrc, int Nout, int map, bf16_t* WT, LAS float* scr, int gw, int ngw, int lane, const float* gk = nullptr) {
    const int nblk = Nout / 32, nitems = (K / 64) * nblk;
    for (int it = gw; it < nitems; it += ngw) {
        const int kb = it / nblk, nb = it % nblk, k0 = 64 * kb, n0 = 32 * nb;
        const int sc = wmap(map, n0 + (lane & 31), Nsrc);
        float wv[32];
#pragma unroll
        for (int i = 0; i < 32; ++i) { const int kk = 2 * i + (lane >> 5); wv[i] = sc >= 0 ? W[(size_t)(k0 + kk) * Nsrc + sc] : 0.f; }
        if (gk) {
#pragma unroll
            for (int i = 0; i < 32; ++i) wv[i] *= gk[k0 + 2 * i + (lane >> 5)];
        }
#pragma unroll
        for (int i = 0; i < 32; ++i) { const int kk = 2 * i + (lane >> 5); scr[kk * 33 + (lane & 31)] = wv[i]; }
        asm volatile("s_waitcnt lgkmcnt(0)" ::: "memory");
        const int c = lane & 7;
#pragma unroll
        for (int j = 0; j < 4; ++j) { const int n = (lane >> 3) + 8 * j; const LAS float* s = scr + (8 * c) * 33 + n;
            u32x4 o; o.x = pk2(s[0 * 33], s[1 * 33]); o.y = pk2(s[2 * 33], s[3 * 33]); o.z = pk2(s[4 * 33], s[5 * 33]); o.w = pk2(s[6 * 33], s[7 * 33]);
            *(u32x4*)(WT + (size_t)(n0 + n) * K + k0 + 8 * c) = o; }
        asm volatile("s_waitcnt lgkmcnt(0)" ::: "memory");
    }
}
__device__ __forceinline__ void conv_group(const float* const* tin, unsigned char* wsb, int l, int group, ldsp lds, int gw, int ngw, int lane, int wid) {
    LAS float* scr = (LAS float*)(lds + wid * 16384);
    bf16_t* W = (bf16_t*)(wsb + WS_W);
    if (group == 0) {
        conv_job(gptr(tin + 4) + (size_t)l * D_ * NGU, D_, NGU, NGU, 1, W + WO_GU1, scr, gw, ngw, lane, gptr(tin + 3) + l * D_);
        conv_job(gptr(tin + 12) + (size_t)l * D_ * 512, D_, 512, 512, 0, W + WO_MKV, scr, gw, ngw, lane);
    } else if (group == 1) {
        conv_job(gptr(tin + 5) + (size_t)l * DFF * D_, DFF, D_, D_, 0, W + WO_D1, scr, gw, ngw, lane);
        if (l < 2) conv_job(gptr(tin + 13) + (size_t)l * D_ * 3340, D_, 3340, LDHA, 3, W + WO_IN, scr, gw, ngw, lane, gptr(tin + 6) + l * D_);
        else { conv_job(gptr(tin + 18) + (size_t)(l - 2) * D_ * 512, D_, 512, 512, 0, W + WO_IN, scr, gw, ngw, lane, gptr(tin + 6) + l * D_);
               conv_job(gptr(tin + 20) + (size_t)(l - 2) * 256 * 1152, 256, 1152, 1280, 2, W + WO_UQ, scr, gw, ngw, lane, gptr(tin + 19) + (l - 2) * 256); }
        conv_job(gptr(tin + 10) + (size_t)l * D_ * D_, D_, D_, D_, 0, W + WO_OUT, scr, gw, ngw, lane);
    } else {
        conv_job(gptr(tin + 8) + (size_t)l * D_ * NGU, D_, NGU, NGU, 1, W + WO_GU2, scr, gw, ngw, lane, gptr(tin + 7) + l * D_);
        conv_job(gptr(tin + 9) + (size_t)l * DFF * D_, DFF, D_, D_, 0, W + WO_D2, scr, gw, ngw, lane);
    }
}

__device__ __forceinline__ void rms_row_bf16(const float* xrow, const float* g, bf16_t* orow, int lane) {
    f32x4 v[4]; float s = 0.f;
#pragma unroll
    for (int j = 0; j < 4; ++j) { v[j] = *(const f32x4*)(xrow + 4 * lane + 256 * j); s += (v[j][0] * v[j][0] + v[j][1] * v[j][1]) + (v[j][2] * v[j][2] + v[j][3] * v[j][3]); }
    const float r = rsqrtf(wave_sum(s) * (1.f / D_) + EPS);
#pragma unroll
    for (int j = 0; j < 4; ++j) { const f32x4 gg = *(const f32x4*)(g + 4 * lane + 256 * j);
        u32x2 w; w.x = pk2(v[j][0] * r * gg[0], v[j][1] * r * gg[1]); w.y = pk2(v[j][2] * r * gg[2], v[j][3] * r * gg[3]);
        *(u32x2*)(orow + 4 * lane + 256 * j) = w; }
}
__device__ __forceinline__ void norm_rows(const float* x, const float* g, bf16_t* xn, int nrows, int gw, int ngw, int lane) {
    for (int m = gw; m < nrows; m += ngw) rms_row_bf16(x + (size_t)m * D_, g, xn + (size_t)m * D_, lane);
}

template <int I> struct SolveRow {
    static __device__ __forceinline__ void run(float (&t)[64], const float (&a)[64], float lanef) {
        SolveRow<I - 1>::run(t, a, lanef);
        float s0 = __builtin_amdgcn_fmed3f(1.f - fabsf(lanef - (float)I), 0.f, 1.f), s1 = 0.f, s2 = 0.f, s3 = 0.f;
        const int ai = __float_as_int(a[I]);
#pragma unroll
        for (int j = 0; j < I; ++j) {
            const float aj = __int_as_float(__builtin_amdgcn_readlane(ai, j));
            if ((j & 3) == 0) s0 -= aj * t[j]; else if ((j & 3) == 1) s1 -= aj * t[j]; else if ((j & 3) == 2) s2 -= aj * t[j]; else s3 -= aj * t[j];
        }
        t[I] = (s0 + s1) + (s2 + s3);
    }
};
template <> struct SolveRow<0> { static __device__ __forceinline__ void run(float (&)[64], const float (&)[64], float) {} };
constexpr int PL_AS = 0, PL_TINV = 16384, PL_GC = 24576, PL_BETA = 24832, PL_QS = 32768, PL_KS = 49152, PL_KTS = 65536, PL_VTS = 81920;
__device__ __forceinline__ void gdn_prep_unit(ldsp L, int u, const bf16_t* hA, const float* convw, float Aexp, float dtb,
                                             bf16_t* negw, bf16_t* qd, bf16_t* kdT, bf16_t* qk, bf16_t* uT, float* dch, int tid, int wid, int lane) {
    const int n = u / 6, h = u - 6 * n, t0 = 64 * n, fr = lane & 15, fq = lane >> 4;
    const int us = h * 256 + n;
    LAS float* GC = (LAS float*)(L + PL_GC); LAS float* BETA = (LAS float*)(L + PL_BETA); LAS float* AS = (LAS float*)(L + PL_AS);
    float beta, gc, glast;
    {
        const bf16_t* rowp = hA + (size_t)(t0 + lane) * LDHA;
        const float braw = bf2f(rowp[3072 + h]), araw = bf2f(rowp[3078 + h]);
        beta = 1.f / (1.f + __expf(-braw));
        const float xs = araw + dtb; const float sp = xs > 20.f ? xs : log1pf(__expf(xs));
        gc = -Aexp * sp;
#pragma unroll
        for (int o = 1; o < 64; o <<= 1) { const float t = __shfl_up(gc, o); if (lane >= o) gc += t; }
        glast = __shfl(gc, 63);
        if (wid == 0) { GC[lane] = gc; BETA[lane] = beta; }
    }
#pragma unroll
    for (int tt = 0; tt < 3; ++tt) {
        const int cb = tt * 768 + h * 128 + 2 * lane;
        float w0[4], w1[4];
#pragma unroll
        for (int k = 0; k < 4; ++k) { const float2 wv = *(const float2*)(convw + k * 2304 + cb); w0[k] = wv.x; w1[k] = wv.y; }
        float x0[11], x1[11];
#pragma unroll
        for (int r = 0; r < 11; ++r) { const int row = t0 + 8 * wid - 3 + r; unsigned v = 0u; if (row >= 0) v = *(const unsigned*)(hA + (size_t)row * LDHA + cb); x0[r] = bflo(v); x1[r] = bfhi(v); }
#pragma unroll
        for (int i = 0; i < 8; ++i) {
            float a0 = 0.f, a1 = 0.f;
#pragma unroll
            for (int k = 0; k < 4; ++k) { a0 += w0[k] * x0[i + k]; a1 += w1[k] * x1[i + k]; }
            a0 = silu_f(a0); a1 = silu_f(a1);
            const int il = 8 * wid + i;
            const float bi = __shfl(beta, il), gi = __shfl(gc, il);
            if (tt < 2) {
                const float ss = wave_sum(a0 * a0 + a1 * a1);
                float rn = rsqrtf(ss + EPS); if (tt == 0) rn *= 0.08838834764831845f;
                a0 *= rn; a1 *= rn;
                *(LAS unsigned*)(L + (tt == 0 ? PL_QS : PL_KS) + swzA(il, lane >> 2) + (lane & 3) * 4) = pk2(a0, a1);
                if (tt == 1) { const float sc = bi * __expf(gi); const unsigned w = pk2(a0 * sc, a1 * sc);
                    *(LAS bf16_t*)(L + PL_KTS + swzB(2 * lane, il >> 3) + (il & 7) * 2) = (bf16_t)(w & 0xffffu);
                    *(LAS bf16_t*)(L + PL_KTS + swzB(2 * lane + 1, il >> 3) + (il & 7) * 2) = (bf16_t)(w >> 16); }
            } else {
                const unsigned w = pk2(a0 * bi, a1 * bi);
                *(LAS bf16_t*)(L + PL_VTS + swzB(2 * lane, il >> 3) + (il & 7) * 2) = (bf16_t)(w & 0xffffu);
                *(LAS bf16_t*)(L + PL_VTS + swzB(2 * lane + 1, il >> 3) + (il & 7) * 2) = (bf16_t)(w >> 16);
            }
        }
    }
    __syncthreads();
#pragma unroll
    for (int pp = 0; pp < 2; ++pp) {
        const int pr = wid + 8 * pp, it = pr >> 2, jt = pr & 3;
        f32x4 accA = {0.f, 0.f, 0.f, 0.f}, accQ = {0.f, 0.f, 0.f, 0.f};
        if (jt <= it) {
#pragma unroll
            for (int s = 0; s < 4; ++s) {
                const bf16x8 X = ldsfrag(L + PL_KS + swzA(16 * jt + fr, 4 * s + fq));
                const bf16x8 Yk = ldsfrag(L + PL_KS + swzA(16 * it + fr, 4 * s + fq));
                const bf16x8 Yq = ldsfrag(L + PL_QS + swzA(16 * it + fr, 4 * s + fq));
                accA = mma(X, Yk, accA); accQ = mma(X, Yq, accQ);
            }
        }
        const int i = 16 * it + fr; const float gci = GC[i], bi = BETA[i];
        f32x4 av, qv;
#pragma unroll
        for (int r = 0; r < 4; ++r) { const int j = 16 * jt + 4 * fq + r; const float dec = __expf(gci - GC[j]);
            av[r] = (j < i) ? bi * accA[r] * dec : 0.f; qv[r] = (j <= i) ? accQ[r] * dec : 0.f; }
        if (jt <= it) *(LAS f32x4*)(AS + i * 64 + 16 * jt + 4 * fq) = av;
        *(u32x2*)(qk + (size_t)us * 4096 + i * 64 + 32 * (jt >> 1) + 8 * fq + 4 * (jt & 1)) = pack4(qv);
    }
    __syncthreads();
    if (wid == 0) {
        float t[64]; const float lanef = (float)lane;
        unsigned asb_ = (unsigned)(uintptr_t)(L + PL_AS); asm volatile("" : "+v"(asb_)); const ldsp asb = (ldsp)asb_;
#pragma unroll
        for (int i = 0; i < 64; ++i) t[i] = 0.f;
        t[0] = __builtin_amdgcn_fmed3f(1.f - fabsf(lanef), 0.f, 1.f);
        float arow[64];
#pragma unroll
        for (int i = 0; i < 64; ++i) arow[i] = *(LAS float*)(asb + (i * 64) * 4 + lane * 4);
        SolveRow<63>::run(t, arow, lanef);
#pragma unroll
        for (int i = 0; i < 64; ++i) *(LAS bf16_t*)(L + PL_TINV + swzB(i, lane >> 3) + (lane & 7) * 2) = (bf16_t)(pk2(t[i], 0.f) & 0xffffu);
        if (lane == 0) dch[us] = __expf(glast);
    } else {
        const int t7 = tid - 64;
        for (int it = t7; it < 1024; it += 448) {
            const int c = it >> 4, oc = it & 15, s = oc >> 2, fqq = oc & 3, d1 = 32 * s + 4 * fqq, d2 = d1 + 16;
            const u32x2 a = *(LAS u32x2*)(L + PL_QS + swzA(c, d1 >> 3) + (d1 & 7) * 2), b = *(LAS u32x2*)(L + PL_QS + swzA(c, d2 >> 3) + (d2 & 7) * 2);
            const float e = __expf(GC[c]);
            u32x4 w; w.x = pk2(bflo(a.x) * e, bfhi(a.x) * e); w.y = pk2(bflo(a.y) * e, bfhi(a.y) * e); w.z = pk2(bflo(b.x) * e, bfhi(b.x) * e); w.w = pk2(bflo(b.y) * e, bfhi(b.y) * e);
            *(u32x4*)(qd + (size_t)us * 8192 + c * 128 + 8 * oc) = w;
        }
        for (int it = t7; it < 1024; it += 448) {
            const int d = it >> 3, oc = it & 7, s = oc >> 2, fqq = oc & 3;
            float v[8];
#pragma unroll
            for (int a = 0; a < 2; ++a)
#pragma unroll
                for (int b = 0; b < 4; ++b) { const int c = 32 * s + 16 * a + 4 * fqq + b;
                    v[4 * a + b] = bf2f(*(LAS bf16_t*)(L + PL_KS + swzA(c, d >> 3) + (d & 7) * 2)) * __expf(glast - GC[c]); }
            u32x4 w; w.x = pk2(v[0], v[1]); w.y = pk2(v[2], v[3]); w.z = pk2(v[4], v[5]); w.w = pk2(v[6], v[7]);
            *(u32x4*)(kdT + (size_t)us * 8192 + d * 64 + 8 * oc) = w;
        }
    }
    __syncthreads();
    {
        const int ct = wid >> 1;
        bf16x8 yt[2];
#pragma unroll
        for (int s2 = 0; s2 < 2; ++s2) yt[s2] = ldsfrag(L + PL_TINV + swzB(16 * ct + fr, 4 * s2 + fq));
#pragma unroll
        for (int q = 0; q < 4; ++q) {
            const int dt = 4 * (wid & 1) + q; f32x4 acc = {0.f, 0.f, 0.f, 0.f};
#pragma unroll
            for (int s2 = 0; s2 < 2; ++s2) acc = mma(ldsfrag(L + PL_KTS + swzB(16 * dt + fr, 4 * s2 + fq)), yt[s2], acc);
            acc = -acc;
            *(u32x2*)(negw + (size_t)us * 8192 + (16 * ct + fr) * 128 + 32 * (dt >> 1) + 8 * fq + 4 * (dt & 1)) = pack4(acc);
        }
        const int et = wid;
        bf16x8 yv[2];
#pragma unroll
        for (int s2 = 0; s2 < 2; ++s2) yv[s2] = ldsfrag(L + PL_VTS + swzB(16 * et + fr, 4 * s2 + fq));
#pragma unroll
        for (int c4 = 0; c4 < 4; ++c4) {
            f32x4 acc = {0.f, 0.f, 0.f, 0.f};
#pragma unroll
            for (int s2 = 0; s2 < 2; ++s2) acc = mma(ldsfrag(L + PL_TINV + swzB(16 * c4 + fr, 4 * s2 + fq)), yv[s2], acc);
            *(u32x2*)(uT + (size_t)us * 8192 + (16 * et + fr) * 64 + 16 * c4 + 4 * fq) = pack4(acc);
        }
    }
    __syncthreads();
}

constexpr int SC_BUF = 57344, SC_NEGW = 0, SC_QD = 16384, SC_KDT = 32768, SC_QK = 49152;
#define SCB() __builtin_amdgcn_sched_barrier(0)
__device__ __forceinline__ void scan_step(ldsp B, f32x4 (&S)[8], const u32x2 (&uc)[4], float dc, bf16_t* orow, int fr, int fq) {
    bf16x8 fa[8], fb[8];
    bf16x8 ys[4];
#pragma unroll
    for (int s = 0; s < 4; ++s) ys[s] = pack8(S[2 * s], S[2 * s + 1]);
    f32x4 vn[4], o[4];
#pragma unroll
    for (int ct = 0; ct < 4; ++ct) { vn[ct] = (f32x4){bflo(uc[ct].x), bfhi(uc[ct].x), bflo(uc[ct].y), bfhi(uc[ct].y)}; o[ct] = (f32x4){0.f, 0.f, 0.f, 0.f}; }
#define LD_P1(dst, s) do { _Pragma("unroll") for (int ct = 0; ct < 4; ++ct) { dst[ct] = ldsfrag(B + SC_NEGW + swzA(16 * ct + fr, 4 * (s) + fq)); dst[4 + ct] = ldsfrag(B + SC_QD + swzA(16 * ct + fr, 4 * (s) + fq)); } } while (0)
#define MM_P1(src, s) do { _Pragma("unroll") for (int ct = 0; ct < 4; ++ct) { vn[ct] = mma(src[ct], ys[s], vn[ct]); o[ct] = mma(src[4 + ct], ys[s], o[ct]); } } while (0)
#define LD_KD(dst, d0) do { _Pragma("unroll") for (int q = 0; q < 4; ++q) { dst[2 * q] = ldsfrag(B + SC_KDT + swzB(16 * ((d0) + q) + fr, fq)); dst[2 * q + 1] = ldsfrag(B + SC_KDT + swzB(16 * ((d0) + q) + fr, 4 + fq)); } } while (0)
#define MM_KD(src, d0) do { _Pragma("unroll") for (int q = 0; q < 4; ++q) { S[(d0) + q] = mma(src[2 * q], yv[0], S[(d0) + q]); } _Pragma("unroll") for (int q = 0; q < 4; ++q) { S[(d0) + q] = mma(src[2 * q + 1], yv[1], S[(d0) + q]); } } while (0)
    LD_P1(fa, 0); SCB();
    LD_P1(fb, 1); SCB(); MM_P1(fa, 0); SCB();
    LD_P1(fa, 2); SCB(); MM_P1(fb, 1); SCB();
    LD_P1(fb, 3); SCB(); MM_P1(fa, 2); SCB();
    LD_KD(fa, 0); SCB(); MM_P1(fb, 3); SCB();
#pragma unroll
    for (int dt = 0; dt < 8; ++dt) S[dt] = S[dt] * dc;
    LD_KD(fb, 4); SCB();
    bf16x8 yv[2];
#pragma unroll
    for (int s2 = 0; s2 < 2; ++s2) yv[s2] = pack8(vn[2 * s2], vn[2 * s2 + 1]);
    MM_KD(fa, 0); SCB();
#pragma unroll
    for (int ct = 0; ct < 4; ++ct) { fa[2 * ct] = ldsfrag(B + SC_QK + swzB(16 * ct + fr, fq)); fa[2 * ct + 1] = ldsfrag(B + SC_QK + swzB(16 * ct + fr, 4 + fq)); }
    SCB(); MM_KD(fb, 4); SCB();
#pragma unroll
    for (int ct = 0; ct < 4; ++ct) o[ct] = mma(fa[2 * ct], yv[0], o[ct]);
#pragma unroll
    for (int ct = 0; ct < 4; ++ct) o[ct] = mma(fa[2 * ct + 1], yv[1], o[ct]);
#pragma unroll
    for (int ct = 0; ct < 4; ++ct)
#pragma unroll
        for (int r = 0; r < 4; ++r) orow[(size_t)(16 * ct + 4 * fq + r) * LDHA] = (bf16_t)(pk2(o[ct][r], 0.f) & 0xffffu);
#undef LD_P1
#undef MM_P1
#undef LD_KD
#undef MM_KD
}
__device__ __forceinline__ void gdn_scan(ldsp L, int h, int eq, const bf16_t* negw, const bf16_t* qd, const bf16_t* kdT, const bf16_t* qk, const bf16_t* uT, const float* dch,
                                        bf16_t* hA, int tid, int wid, int lane) {
#define SC_BAR() asm volatile("s_waitcnt lgkmcnt(0)\n\ts_barrier" ::: "memory")
    const int fr = lane & 15, fq = lane >> 4, e0 = 32 * eq + 16 * wid;
    if (wid < 2) {
        f32x4 S[8];
#pragma unroll
        for (int d = 0; d < 8; ++d) S[d] = (f32x4){0.f, 0.f, 0.f, 0.f};
        u32x2 ua[4], ub[4]; float da, db;
#define SC_LOADU(un, dcn, nn) do { const size_t u_ = (size_t)h * 256 + (nn); \
        _Pragma("unroll") for (int ct = 0; ct < 4; ++ct) un[ct] = *(const u32x2*)(uT + u_ * 8192 + (size_t)(e0 + fr) * 64 + 16 * ct + 4 * fq); dcn = dch[u_]; } while (0)
        SC_LOADU(ua, da, 0); SC_LOADU(ub, db, 1);
        SC_BAR();
        for (int n = 0; n < 256; n += 2) {
            { u32x2 uc[4]; const float dc = da;
#pragma unroll
              for (int ct = 0; ct < 4; ++ct) uc[ct] = ua[ct];
              SC_LOADU(ua, da, (n + 2 < 256 ? n + 2 : 255));
              scan_step(L, S, uc, dc, hA + (size_t)(64 * n) * LDHA + h * 128 + e0 + fr, fr, fq);
              SC_BAR(); }
            { u32x2 uc[4]; const float dc = db;
#pragma unroll
              for (int ct = 0; ct < 4; ++ct) uc[ct] = ub[ct];
              SC_LOADU(ub, db, (n + 3 < 256 ? n + 3 : 255));
              scan_step(L + SC_BUF, S, uc, dc, hA + (size_t)(64 * (n + 1)) * LDHA + h * 128 + e0 + fr, fr, fq);
              SC_BAR(); }
        }
#undef SC_LOADU
    } else {
        const int w6 = wid - 2;
        u32x4 ra[10], rb[10];
#define SC_LOADS(r, nn) do { const size_t u_ = (size_t)h * 256 + (nn); \
        _Pragma("unroll") for (int i_ = 0; i_ < 10; ++i_) { const int idx_ = (w6 + 6 * i_) < 56 ? (w6 + 6 * i_) : 55; { const int a_ = idx_ >> 4, c_ = (idx_ & 15) * 64 + lane; \
            const bf16_t* b_ = a_ == 0 ? negw : a_ == 1 ? qd : a_ == 2 ? kdT : qk; \
            r[i_] = *(const u32x4*)(b_ + u_ * (a_ == 3 ? 4096 : 8192) + (size_t)c_ * 8); } } } while (0)
#define SC_STORES(r, buf) do { ldsp B_ = L + (buf) * SC_BUF; \
        _Pragma("unroll") for (int i_ = 0; i_ < 10; ++i_) { const int idx_ = (w6 + 6 * i_) < 56 ? (w6 + 6 * i_) : 55; { const int a_ = idx_ >> 4, c_ = (idx_ & 15) * 64 + lane; \
            const int off_ = a_ < 2 ? a_ * 16384 + swzA(c_ >> 4, c_ & 15) : (a_ == 2 ? SC_KDT : SC_QK) + swzB(c_ >> 3, c_ & 7); \
            *(LAS u32x4*)(B_ + off_) = r[i_]; } } } while (0)
        SC_LOADS(ra, 0); SC_STORES(ra, 0);
        SC_LOADS(rb, 1); SC_LOADS(ra, 2);
        SC_BAR();
        for (int n = 0; n < 256; n += 2) {
            SC_STORES(rb, 1);
            SC_LOADS(rb, (n + 3 < 256 ? n + 3 : 255));
            SC_BAR();
            SC_STORES(ra, 0);
            SC_LOADS(ra, (n + 4 < 256 ? n + 4 : 255));
            SC_BAR();
        }
#undef SC_LOADS
#undef SC_STORES
    }
}
#undef SC_BAR

__device__ __forceinline__ void gdn_out_rows(const bf16_t* hA, const float* gain, bf16_t* mix, int gw, int ngw, int lane) {
    const float2 gg = *(const float2*)(gain + 2 * lane);
    for (int m0 = gw; m0 < S_; m0 += 2 * ngw) {
        unsigned ov[2][6], gv[2][6];
#pragma unroll
        for (int q = 0; q < 2; ++q) {
            const int m = m0 + q * ngw < S_ ? m0 + q * ngw : m0;
            const bf16_t* rowp = hA + (size_t)m * LDHA;
#pragma unroll
            for (int h = 0; h < 6; ++h) { ov[q][h] = *(const unsigned*)(rowp + h * 128 + 2 * lane); gv[q][h] = *(const unsigned*)(rowp + 2304 + h * 128 + 2 * lane); }
        }
#pragma unroll
        for (int q = 0; q < 2; ++q) {
            const int m = m0 + q * ngw;
            if (m < S_) {
#pragma unroll
                for (int h = 0; h < 6; ++h) {
                    const float o0 = bflo(ov[q][h]), o1 = bfhi(ov[q][h]);
                    const float r = rsqrtf(wave_sum(o0 * o0 + o1 * o1) * (1.f / 128.f) + EPS);
                    *(unsigned*)(mix + (size_t)m * D_ + h * 128 + 2 * lane) = pk2(o0 * r * gg.x * silu_f(bflo(gv[q][h])), o1 * r * gg.y * silu_f(bfhi(gv[q][h])));
                }
            }
        }
    }
}

__device__ __forceinline__ int swzV(int r, int ch) { return r * 512 + ((ch ^ (r & 15)) << 4); }
__device__ __forceinline__ void mem_attn(ldsp L, const bf16_t* qsrc, int ldq, int qcol, const bf16_t* memK, const bf16_t* memVt, bf16_t* mix, int tid, int wid, int lane) {
    const int fr = lane & 15, fq = lane >> 4;
    const float SCL = 0.125f * 1.4426950408889634f;
    for (int unit = blockIdx.x; unit < 256; unit += gridDim.x) {
        const int hm = unit & 3, tb = unit >> 2;
#pragma unroll
        for (int i = 0; i < 4; ++i) { const int g = tid + 512 * i;
            *(LAS u32x4*)(L + swzB(g >> 3, g & 7)) = *(const u32x4*)(memK + (size_t)(g >> 3) * 256 + hm * 64 + (g & 7) * 8);
            *(LAS u32x4*)(L + 32768 + swzV(g >> 5, g & 31)) = *(const u32x4*)(memVt + (size_t)(hm * 64 + (g >> 5)) * 256 + (g & 31) * 8); }
        __syncthreads();
        for (int tl = wid; tl < 16; tl += NW) {
            const int tok0 = 256 * tb + 16 * tl;
            bf16x8 yq[2];
#pragma unroll
            for (int s = 0; s < 2; ++s) yq[s] = gfrag(qsrc + (size_t)(tok0 + fr) * ldq + qcol + hm * 64 + 32 * s + 8 * fq);
            f32x4 sc[16];
#pragma unroll
            for (int kb = 0; kb < 4; ++kb) {
                bf16x8 xk[8];
#pragma unroll
                for (int q = 0; q < 4; ++q) { xk[2 * q] = ldsfrag(L + swzB(16 * (4 * kb + q) + fr, fq)); xk[2 * q + 1] = ldsfrag(L + swzB(16 * (4 * kb + q) + fr, 4 + fq)); }
                SCB();
#pragma unroll
                for (int q = 0; q < 4; ++q) { sc[4 * kb + q] = mma(xk[2 * q], yq[0], (f32x4){0.f, 0.f, 0.f, 0.f}); sc[4 * kb + q] = mma(xk[2 * q + 1], yq[1], sc[4 * kb + q]); }
                SCB();
            }
            float mx = -1e30f;
#pragma unroll
            for (int kt = 0; kt < 16; ++kt)
#pragma unroll
                for (int r = 0; r < 4; ++r) mx = fmaxf(mx, sc[kt][r]);
            mx = fmaxf(mx, __shfl_xor(mx, 16)); mx = fmaxf(mx, __shfl_xor(mx, 32));
            float l = 0.f;
#pragma unroll
            for (int kt = 0; kt < 16; ++kt)
#pragma unroll
                for (int r = 0; r < 4; ++r) { const float pv = __builtin_amdgcn_exp2f((sc[kt][r] - mx) * SCL); sc[kt][r] = pv; l += pv; }
            l += __shfl_xor(l, 16); l += __shfl_xor(l, 32);
            const float rl = 1.f / l;
            f32x4 o[4];
#pragma unroll
            for (int dt = 0; dt < 4; ++dt) o[dt] = (f32x4){0.f, 0.f, 0.f, 0.f};
#pragma unroll
            for (int s = 0; s < 8; ++s) {
                const bf16x8 yp = pack8(sc[2 * s], sc[2 * s + 1]);
                bf16x8 xv[4];
#pragma unroll
                for (int dt = 0; dt < 4; ++dt) xv[dt] = ldsfrag(L + 32768 + swzV(16 * dt + fr, 4 * s + fq));
                SCB();
#pragma unroll
                for (int dt = 0; dt < 4; ++dt) o[dt] = mma(xv[dt], yp, o[dt]);
                SCB();
            }
#pragma unroll
            for (int dt = 0; dt < 4; ++dt) *(u32x2*)(mix + (size_t)(tok0 + fr) * D_ + 768 + hm * 64 + 16 * dt + 4 * fq) = pack4(o[dt] * rl);
        }
        __syncthreads();
    }
}

constexpr int AT_BUF = 40960, AT_KN = 0, AT_KR = 16384, AT_VT = 24576, AT_CTL = 2 * AT_BUF, AT_QR = 2 * AT_BUF + 1024;
__device__ __forceinline__ void mla_attn(ldsp L, const bf16_t* Qc, const bf16_t* Kc, const bf16_t* Vt, bf16_t* mix, unsigned* ctr, int tid, int wid, int lane) {
    const int fr = lane & 15, fq = lane >> 4;
    LAS int* ctl = (LAS int*)(L + AT_CTL);
    for (;;) {
        if (tid == 0) ctl[0] = (int)atomicAdd(ctr, 1u);
        __syncthreads();
        const int item = ctl[0];
        __syncthreads();
        if (item >= 384) break;
        const int qb = 63 - item / 6, h = item % 6;
        const int NT = 4 * qb + 4, q0 = 256 * qb + 32 * wid, tmax = 4 * qb + (wid >> 1);
        bf16x8 Q[2][4];
        const bf16_t* qrow = Qc + ((size_t)(q0 + fr) * 6 + h) * 192 + 8 * fq;
#pragma unroll
        for (int qs = 0; qs < 2; ++qs)
#pragma unroll
            for (int s = 0; s < 4; ++s) Q[qs][s] = gfrag(qrow + (size_t)qs * 16 * 1152 + 32 * s);
#pragma unroll
        for (int qs = 0; qs < 2; ++qs)
#pragma unroll
            for (int s = 0; s < 2; ++s) *(LAS bf16x8*)(L + AT_QR + wid * 4096 + (qs * 2 + s) * 1024 + lane * 16) = gfrag(qrow + (size_t)qs * 16 * 1152 + 128 + 32 * s);
        f32x4 O[2][8];
#pragma unroll
        for (int qs = 0; qs < 2; ++qs)
#pragma unroll
            for (int dt = 0; dt < 8; ++dt) O[qs][dt] = (f32x4){0.f, 0.f, 0.f, 0.f};
        float mrow[2] = {0.f, 0.f}, lrow[2] = {0.f, 0.f};
        const bf16_t* Kh = Kc + (size_t)h * S_ * 192; const bf16_t* Vh = Vt + (size_t)h * 128 * S_;
        const int rA = lane >> 4, cA = lane & 15, rB = lane >> 3, cB = lane & 7;
#define AT_DMA(t, buf) do { ldsp B_ = L + (buf) * AT_BUF; const size_t kb_ = (size_t)(t) * 64; \
        _Pragma("unroll") for (int i_ = 0; i_ < 2; ++i_) { const int pi_ = wid + 8 * i_, r_ = 4 * pi_ + rA; \
            __builtin_amdgcn_global_load_lds((const unsigned*)(Kh + (kb_ + r_) * 192 + ((cA ^ (r_ & 15)) << 3)), (LAS unsigned*)(B_ + AT_KN + pi_ * 1024), 16, 0, 0); } \
        { const int r_ = 8 * wid + rB; \
            __builtin_amdgcn_global_load_lds((const unsigned*)(Kh + (kb_ + r_) * 192 + 128 + ((cB ^ (r_ & 7)) << 3)), (LAS unsigned*)(B_ + AT_KR + wid * 1024), 16, 0, 0); } \
        _Pragma("unroll") for (int i_ = 0; i_ < 2; ++i_) { const int pi_ = wid + 8 * i_, r_ = 8 * pi_ + rB; \
            __builtin_amdgcn_global_load_lds((const unsigned*)(Vh + (size_t)r_ * S_ + kb_ + ((cB ^ (r_ & 7)) << 3)), (LAS unsigned*)(B_ + AT_VT + pi_ * 1024), 16, 0, 0); } } while (0)
        AT_DMA(0, 0);
        asm volatile("s_waitcnt vmcnt(0)" ::: "memory");
        __syncthreads();
        for (int t = 0; t < NT; ++t) {
            if (t + 1 < NT) AT_DMA(t + 1, (t + 1) & 1);
            if (t <= tmax) {
                ldsp B = L + (t & 1) * AT_BUF;
                f32x4 sc[2][4];
                bf16x8 Qr[2][2];
#pragma unroll
                for (int qs = 0; qs < 2; ++qs)
#pragma unroll
                    for (int s = 0; s < 2; ++s) Qr[qs][s] = ldsfrag(L + AT_QR + wid * 4096 + (qs * 2 + s) * 1024 + lane * 16);
                bf16x8 xa[6], v0[8];
#define AT_LDK(dst, kt) do { _Pragma("unroll") for (int s = 0; s < 4; ++s) dst[s] = ldsfrag(B + AT_KN + swzA(16 * (kt) + fr, 4 * s + fq)); \
                             dst[4] = ldsfrag(B + AT_KR + swzB(16 * (kt) + fr, fq)); dst[5] = ldsfrag(B + AT_KR + swzB(16 * (kt) + fr, 4 + fq)); } while (0)
#define AT_MMK(src, kt) do { sc[0][kt] = (f32x4){-mrow[0], -mrow[0], -mrow[0], -mrow[0]}; sc[1][kt] = (f32x4){-mrow[1], -mrow[1], -mrow[1], -mrow[1]}; \
                             _Pragma("unroll") for (int s = 0; s < 4; ++s) { sc[0][kt] = mma(src[s], Q[0][s], sc[0][kt]); sc[1][kt] = mma(src[s], Q[1][s], sc[1][kt]); } \
                             _Pragma("unroll") for (int s = 0; s < 2; ++s) { sc[0][kt] = mma(src[4 + s], Qr[0][s], sc[0][kt]); sc[1][kt] = mma(src[4 + s], Qr[1][s], sc[1][kt]); } } while (0)
#define AT_LDV(dst, d0) do { _Pragma("unroll") for (int q = 0; q < 4; ++q) { dst[2 * q] = ldsfrag(B + AT_VT + swzB(16 * ((d0) + q) + fr, fq)); dst[2 * q + 1] = ldsfrag(B + AT_VT + swzB(16 * ((d0) + q) + fr, 4 + fq)); } } while (0)
#define AT_MMV(src, d0) do { _Pragma("unroll") for (int q = 0; q < 4; ++q) { \
                             O[0][(d0) + q] = mma(src[2 * q], yp[0][0], O[0][(d0) + q]); O[1][(d0) + q] = mma(src[2 * q], yp[1][0], O[1][(d0) + q]); } \
                             _Pragma("unroll") for (int q = 0; q < 4; ++q) { \
                             O[0][(d0) + q] = mma(src[2 * q + 1], yp[0][1], O[0][(d0) + q]); O[1][(d0) + q] = mma(src[2 * q + 1], yp[1][1], O[1][(d0) + q]); } } while (0)
                AT_LDK(xa, 0); SCB(); AT_MMK(xa, 0); SCB();
                AT_LDK(xa, 1); SCB(); AT_MMK(xa, 1); SCB();
                AT_LDK(xa, 2); SCB(); AT_MMK(xa, 2); SCB();
                AT_LDK(xa, 3); SCB(); AT_MMK(xa, 3); SCB(); AT_LDV(v0, 0); SCB();
                bf16x8 yp[2][2];
#pragma unroll
                for (int qs = 0; qs < 2; ++qs) {
                    float mx = -1e30f;
#pragma unroll
                    for (int kt = 0; kt < 4; ++kt)
#pragma unroll
                        for (int r = 0; r < 4; ++r) mx = fmaxf(mx, sc[qs][kt][r]);
                    mx = fmaxf(mx, __shfl_xor(mx, 16)); mx = fmaxf(mx, __shfl_xor(mx, 32));
                    if (__any(t == 0 || mx > 8.f)) {
                        const float dl = t == 0 ? mx : fmaxf(mx, 0.f), alpha = __builtin_amdgcn_exp2f(-dl);
                        mrow[qs] += dl; lrow[qs] *= alpha;
#pragma unroll
                        for (int kt = 0; kt < 4; ++kt) sc[qs][kt] = sc[qs][kt] - dl;
#pragma unroll
                        for (int dt = 0; dt < 8; ++dt) O[qs][dt] = O[qs][dt] * alpha;
                    }
                    float ls = 0.f;
#pragma unroll
                    for (int kt = 0; kt < 4; ++kt)
#pragma unroll
                        for (int r = 0; r < 4; ++r) { const float pv = __builtin_amdgcn_exp2f(sc[qs][kt][r]); sc[qs][kt][r] = pv; ls += pv; }
                    lrow[qs] += ls;
                    yp[qs][0] = pack8(sc[qs][0], sc[qs][1]); yp[qs][1] = pack8(sc[qs][2], sc[qs][3]);
                }
                SCB(); AT_MMV(v0, 0); SCB(); AT_LDV(v0, 4); SCB(); AT_MMV(v0, 4); SCB();
#undef AT_LDK
#undef AT_MMK
#undef AT_LDV
#undef AT_MMV
            }
            asm volatile("s_waitcnt vmcnt(0)" ::: "memory");
            __syncthreads();
        }
#undef AT_DMA
#pragma unroll
        for (int qs = 0; qs < 2; ++qs) {
            float l = lrow[qs]; l += __shfl_xor(l, 16); l += __shfl_xor(l, 32);
            const float rl = 1.f / l;
#pragma unroll
            for (int dt = 0; dt < 8; ++dt) *(u32x2*)(mix + (size_t)(q0 + 16 * qs + fr) * D_ + h * 128 + 16 * dt + 4 * fq) = pack4(O[qs][dt] * rl);
        }
    }
}


#define XB_TMO      128
#define XB_XCNT(j)  (256  + 64 * (j))
#define XB_XSUB(j)  (1280 + 64 * (j))
#define XB_XGEN(j)  (2304 + 64 * (j))
#define XB_TOP      3328
#define XB_TOPGEN   3392
#define XCD_BAR_WORDS 3456
#define XB_SPIN_CAP (1u << 18)

__device__ __forceinline__ unsigned xb_ld(unsigned* p)              { return __hip_atomic_load(p, __ATOMIC_RELAXED, __HIP_MEMORY_SCOPE_AGENT); }
__device__ __forceinline__ unsigned xb_add(unsigned* p, unsigned v) { return __hip_atomic_fetch_add(p, v, __ATOMIC_RELAXED, __HIP_MEMORY_SCOPE_AGENT); }
__device__ __forceinline__ unsigned xb_xcc_id() { return (unsigned)__builtin_amdgcn_s_getreg((3 << 11) | 20) & 0xFu; }
#define XB_SPIN(cond, bar) do { unsigned _sp = 0; while (cond) { __builtin_amdgcn_s_sleep(0);     \
    if ((++_sp & 255u) == 0u) { if (xb_ld(&(bar)[XB_TMO])) break; if (_sp > XB_SPIN_CAP) { atomicAdd(&(bar)[XB_TMO], 1u); break; } } } } while (0)

struct XcdBarrier {
    unsigned* bar; unsigned x;
    volatile LAS unsigned* st;
};

__device__ __forceinline__ XcdBarrier xcd_barrier_post(unsigned* bar, volatile LAS unsigned* st) {
    XcdBarrier b; b.bar = bar; b.x = xb_xcc_id(); b.st = st;
    if (threadIdx.x == 0) (void)xb_add(&bar[XB_XCNT(b.x)], 1u);
    return b;
}
__device__ __forceinline__ void xcd_barrier_complete(unsigned* bar, unsigned x, unsigned& nloc, unsigned& nx) {
    const unsigned G = gridDim.x * gridDim.y * gridDim.z;
    unsigned sum, cnt, mine, sp = 0u;
    for (;;) {
        sum = 0u; cnt = 0u; mine = 0u;
#pragma unroll
        for (unsigned j = 0; j < 16; ++j) { const unsigned c = xb_ld(&bar[XB_XCNT(j)]); sum += c; cnt += (c > 0u) ? 1u : 0u; mine = (j == x) ? c : mine; }
        if (sum == G) break;
        __builtin_amdgcn_s_sleep(1);
        if ((++sp & 255u) == 0u) { if (xb_ld(&bar[XB_TMO])) break; if (sp > XB_SPIN_CAP) { atomicAdd(&bar[XB_TMO], 1u); break; } }
    }
    nloc = mine > 0u ? mine : 1u; nx = cnt > 0u ? cnt : 1u;
}

__device__ __forceinline__ void xcd_barrier(const XcdBarrier& b) {
    asm volatile("s_waitcnt vmcnt(0)" ::: "memory");
    __syncthreads();
    if (threadIdx.x == 0) {
        unsigned* bar = b.bar;
        __builtin_amdgcn_s_waitcnt(0);
        unsigned nloc = b.st[0], nx = b.st[1];
        if (nloc == 0u) { xcd_barrier_complete(bar, b.x, nloc, nx); b.st[0] = nloc; b.st[1] = nx; }
        const unsigned old = xb_add(&bar[XB_XSUB(b.x)], 1u);
        const unsigned gen = old / nloc;
        if (old + 1u == (gen + 1u) * nloc) {
            __builtin_amdgcn_fence(__ATOMIC_RELEASE, "agent");
            asm volatile("s_waitcnt vmcnt(0)" ::: "memory");
            const unsigned og = xb_add(&bar[XB_TOP], 1u);
            const unsigned tg = og / nx;
            if (og + 1u == (tg + 1u) * nx) xb_add(&bar[XB_TOPGEN], 1u);
            else XB_SPIN(xb_ld(&bar[XB_TOPGEN]) == tg, bar);
            __builtin_amdgcn_fence(__ATOMIC_ACQUIRE, "agent");
            xb_add(&bar[XB_XGEN(b.x)], 1u);
            asm volatile("s_waitcnt vmcnt(0)" ::: "memory");
        } else {
            XB_SPIN(xb_ld(&bar[XB_XGEN(b.x)]) == gen, bar);
            __builtin_amdgcn_fence(__ATOMIC_ACQUIRE, "agent");
            asm volatile("s_waitcnt vmcnt(0)" ::: "memory");
        }
    }
    __syncthreads();
}

#ifndef RP_GU
#define RP_GU 1
#endif
#ifndef RP_INA
#define RP_INA 1
#endif
#ifndef RP_PREP
#define RP_PREP 1
#endif
#ifndef RP_SCAN
#define RP_SCAN 1
#endif
#ifndef RP_ATTN
#define RP_ATTN 1
#endif
#ifndef RP_MEM
#define RP_MEM 1
#endif
#ifndef RP_CONV
#define RP_CONV 1
#endif
#ifndef RP_UQ
#define RP_UQ 1
#endif
#ifndef RP_OUTROWS
#define RP_OUTROWS 1
#endif
#ifndef RP_P0
#define RP_P0 1
#endif
#ifndef REP_MEM
#define REP_MEM 1
#endif
#ifndef REP_ROWS
#define REP_ROWS 1
#endif
#ifndef REP_RES
#define REP_RES 1
#endif
#ifndef REP_INPROJ
#define REP_INPROJ 1
#endif
#ifndef REP_CONV
#define REP_CONV 1
#endif
#ifndef REP_GU
#define REP_GU 1
#endif
#ifndef REP_ATTN
#define REP_ATTN 1
#endif
#ifndef REP_SCAN
#define REP_SCAN 1
#endif
#ifndef REP_SYNC
#define REP_SYNC 1
#endif
#ifndef REP_PREP
#define REP_PREP 1
#endif
#define PHASE_IDS int tid_o_ = threadIdx.x; asm volatile("" : "+v"(tid_o_)); const int tid = tid_o_, lane = tid & 63, wid = __builtin_amdgcn_readfirstlane(tid >> 6), gw = bx * NW + wid; (void)lane; (void)gw; (void)tid
#define GSYNC_CG() do { asm volatile("s_waitcnt vmcnt(0) lgkmcnt(0)" ::: "memory"); grid.sync(); } while (0)
#define GSYNC() do { for (int r_ = 0; r_ < REP_SYNC; ++r_) xcd_barrier(xbar); } while (0)
#define CONV_UPPER(l_, grp_) do { if (2 * bx >= G) conv_group((const float* const*)(ws_ + WS_TAB), ws_, (l_), (grp_), L, (bx - G / 2) * NW + wid, (G - G / 2) * NW, lane, wid); __syncthreads();   } while (0)
#define SSQ(k) (WSP(float, WS_SSQ) + (size_t)(k) * S_ * 16)
#define WSP(T, off) ((T*)(ws_ + (off)))
#define INP(k) gptr(((const float* const*)(ws_ + WS_TAB)) + (k))
#define PHASE_BEGIN GAS unsigned char* wsg_ = (GAS unsigned char*)p.ws; int bx = blockIdx.x; asm volatile("" : "+s"(wsg_), "+s"(bx)); unsigned char* ws_ = (unsigned char*)wsg_; PHASE_IDS
__global__ void __launch_bounds__(NTHREADS, 2) fwd_megakernel(Params p) {
    extern __shared__ __attribute__((aligned(16))) unsigned char lds_raw[];
    cg::grid_group grid = cg::this_grid();
    ldsp L = (ldsp)lds_raw;
    const int G = gridDim.x, ngw = G * NW;
    volatile LAS unsigned* xst = (volatile LAS unsigned*)(L + XB_LDS_OFF);
    if (threadIdx.x < 2) xst[threadIdx.x] = 0u;
    __syncthreads();
    const XcdBarrier xbar = xcd_barrier_post((unsigned*)(p.ws + WS_XBAR), xst);

    {
        PHASE_BEGIN;
        if (tid == 0) {
            const float** T = (const float**)(ws_ + WS_TAB);
#pragma unroll
            for (int k = 0; k < 26; ++k) T[k] = p.in[k];
            float* TF = (float*)(ws_ + WS_TAB + 512);
#pragma unroll
            for (int k = 0; k < 32; ++k) TF[k] = p.invf[k];
        }
        asm volatile("s_waitcnt vmcnt(0)" ::: "memory");
        __syncthreads();
        __builtin_amdgcn_fence(__ATOMIC_ACQUIRE, "agent");
        const float* const* tin = (const float* const*)(ws_ + WS_TAB);
        LAS float* scr = (LAS float*)(L + wid * 16384);
        conv_group(tin, ws_, 0, 0, L, gw, ngw, lane, wid);
        conv_job(INP(22), D_, 320, 512, 0, WSP(bf16_t, WS_DKVT), scr, gw, ngw, lane, INP(21));
        conv_job(INP(24), 256, 1536, 768, 4, WSP(bf16_t, WS_UKT), scr, gw, ngw, lane);
        conv_job(INP(24), 256, 1536, 768, 5, WSP(bf16_t, WS_UVT), scr, gw, ngw, lane);
        norm_rows(INP(1), INP(11), WSP(bf16_t, WS_MEMN), 256, gw, ngw, lane);
        {
            const float* xin = INP(0); bf16_t* XB = WSP(bf16_t, WS_XN); float* sq0 = SSQ(12);
            for (int m = gw; m < S_; m += ngw) {
                float s = 0.f;
#pragma unroll
                for (int j = 0; j < 4; ++j) { const f32x4 v = *(const f32x4*)(xin + (size_t)m * D_ + 4 * lane + 256 * j);
                    u32x2 w; w.x = pk2(v[0], v[1]); w.y = pk2(v[2], v[3]); *(u32x2*)(XB + (size_t)m * D_ + 4 * lane + 256 * j) = w;
                    const float y0 = bflo(w.x), y1 = bfhi(w.x), y2 = bflo(w.y), y3 = bfhi(w.y); s += (y0 * y0 + y1 * y1) + (y2 * y2 + y3 * y3); }
                s = wave_sum(s);
                if (lane < 16) sq0[(size_t)m * 16 + lane] = lane == 0 ? s : 0.f;
            }
        }
        const int* positions = (const int*)INP(2);
        float2* ROPE = WSP(float2, WS_ROPE);
        for (int i = bx * NTHREADS + tid; i < S_ * 32; i += G * NTHREADS) {
            const int row = i >> 5, j = i & 31;
            const double a = (double)positions[row] * (double)((const float*)(ws_ + WS_TAB + 512))[j];
            const double rev = a * 0.15915494309189535; const float f = (float)(rev - rint(rev));
            ROPE[i] = make_float2(__builtin_amdgcn_cosf(f), __builtin_amdgcn_sinf(f));
        }
    }
    GSYNC_CG();

    for (int l = 0; l < 4; ++l) {
        const bool isA = l < 2;
        for (int rp_ = 0; rp_ < RP_GU; ++rp_) { PHASE_BEGIN; EpiSwiglu E{WSP(bf16_t, WS_H), l == 0 ? SSQ(12) : SSQ(3 * (l - 1) + 2)}; run_gemm(L, WSP(bf16_t, WS_XN), WSP(bf16_t, WS_W) + WO_GU1, S_, NGU, D_, bx, E); CONV_UPPER(l, 1); }
        {
            PHASE_BEGIN;
            EpiStore<true> Ek{WSP(bf16_t, WS_MEMK), 256, nullptr}; run_gemm(L, WSP(bf16_t, WS_MEMN), WSP(bf16_t, WS_W) + WO_MKV, 256, 256, D_, (bx + 1) % G, Ek);
            EpiStore<false> Ev{WSP(bf16_t, WS_MEMVT), 256, nullptr}; run_gemm(L, WSP(bf16_t, WS_W) + WO_MKV + (size_t)256 * D_, WSP(bf16_t, WS_MEMN), 256, 256, D_, (bx + 2) % G, Ev);
        }
        GSYNC();
        { PHASE_BEGIN; EpiResid E{WSP(bf16_t, WS_XN), 0.5f, SSQ(3 * l)}; run_gemm(L, WSP(bf16_t, WS_H), WSP(bf16_t, WS_W) + WO_D1, S_, D_, DFF, bx, E); }
        GSYNC();
        if (isA) {
            for (int rp_ = 0; rp_ < RP_INA; ++rp_) { PHASE_BEGIN; EpiStore<true> E{WSP(bf16_t, WS_HA), LDHA, SSQ(3 * l)}; run_gemm(L, WSP(bf16_t, WS_XN), WSP(bf16_t, WS_W) + WO_IN, S_, LDHA, D_, bx, E); CONV_UPPER(l, 2); }
            GSYNC();
            {
                PHASE_BEGIN;
                const float* convw = INP(14) + (size_t)l * 4 * 2304;
                for (int rp_ = 0; rp_ < RP_PREP; ++rp_) for (int u = bx; u < 1536; u += G) {
                    const int h = u % 6;
                    gdn_prep_unit(L, u, WSP(bf16_t, WS_HA), convw, __expf(INP(15)[l * 6 + h]), INP(16)[l * 6 + h],
                                  WSP(bf16_t, WS_NEGW), WSP(bf16_t, WS_QD), WSP(bf16_t, WS_KDT), WSP(bf16_t, WS_QK), WSP(bf16_t, WS_UT), WSP(float, WS_DCH), tid, wid, lane);
                }
            }
            for (int rp_ = 0; rp_ < RP_MEM; ++rp_) { PHASE_BEGIN; mem_attn(L, WSP(bf16_t, WS_HA), LDHA, QMA, WSP(bf16_t, WS_MEMK), WSP(bf16_t, WS_MEMVT), WSP(bf16_t, WS_MIX), tid, wid, lane); }
            GSYNC();
            for (int rp_ = 0; rp_ < RP_SCAN; ++rp_) if (blockIdx.x < 24) { PHASE_BEGIN; gdn_scan(L, bx >> 2, bx & 3, WSP(bf16_t, WS_NEGW), WSP(bf16_t, WS_QD), WSP(bf16_t, WS_KDT), WSP(bf16_t, WS_QK),
                                  WSP(bf16_t, WS_UT), WSP(float, WS_DCH), WSP(bf16_t, WS_HA), tid, wid, lane); }
            GSYNC();
            for (int rp_ = 0; rp_ < RP_OUTROWS; ++rp_) { PHASE_BEGIN; gdn_out_rows(WSP(bf16_t, WS_HA), INP(17) + l * 128, WSP(bf16_t, WS_MIX), gw, ngw, lane); }
            GSYNC();
        } else {
            { PHASE_BEGIN; EpiInB E{WSP(bf16_t, WS_HB), WSP(bf16_t, WS_CQN), SSQ(3 * l), WSP(float, WS_SQQ)}; run_gemm(L, WSP(bf16_t, WS_XN), WSP(bf16_t, WS_W) + WO_IN, S_, LDHB, D_, bx, E); CONV_UPPER(l, 2); }
            GSYNC();
            for (int rp_ = 0; rp_ < RP_UQ; ++rp_) { PHASE_BEGIN; EpiQ E{WSP(bf16_t, WS_QCAT), WSP(float2, WS_ROPE), 0.07216878364870323f * 1.4426950408889634f, WSP(float, WS_SQQ)}; run_gemm(L, WSP(bf16_t, WS_CQN), WSP(bf16_t, WS_W) + WO_UQ, S_, 1280, 256, bx, E); }
            GSYNC();
            for (int rp_ = 0; rp_ < RP_MEM; ++rp_) { PHASE_BEGIN; mem_attn(L, WSP(bf16_t, WS_HB), LDHB, QMB, WSP(bf16_t, WS_MEMK), WSP(bf16_t, WS_MEMVT), WSP(bf16_t, WS_MIX), tid, wid, lane); }
            for (int rp_ = 0; rp_ < RP_ATTN; ++rp_) { PHASE_BEGIN; mla_attn(L, WSP(bf16_t, WS_QCAT), WSP(bf16_t, WS_KCAT), WSP(bf16_t, WS_VT), WSP(bf16_t, WS_MIX), WSP(unsigned, WS_CTL) + 64 * (l - 2) + 128 * rp_, tid, wid, lane); __syncthreads(); }
            GSYNC();
        }
        { PHASE_BEGIN; EpiResid E{WSP(bf16_t, WS_XN), 1.0f, SSQ(3 * l + 1)}; run_gemm(L, WSP(bf16_t, WS_MIX), WSP(bf16_t, WS_W) + WO_OUT, S_, D_, D_, bx, E); }
        GSYNC();
        for (int rp_ = 0; rp_ < RP_GU; ++rp_) { PHASE_BEGIN; EpiSwiglu E{WSP(bf16_t, WS_H), SSQ(3 * l + 1)}; run_gemm(L, WSP(bf16_t, WS_XN), WSP(bf16_t, WS_W) + WO_GU2, S_, NGU, D_, bx, E); if (l < 3) CONV_UPPER(l + 1, 0); }
        GSYNC();
        { PHASE_BEGIN; EpiResid E{WSP(bf16_t, WS_XN), 0.5f, SSQ(3 * l + 2)}; run_gemm(L, WSP(bf16_t, WS_H), WSP(bf16_t, WS_W) + WO_D2, S_, D_, DFF, bx, E); }
        GSYNC();
        if (l == 1) {
            { PHASE_BEGIN; EpiStore<true> E{WSP(bf16_t, WS_HB), 512, SSQ(5)}; run_gemm(L, WSP(bf16_t, WS_XN), WSP(bf16_t, WS_DKVT), S_, 512, D_, bx, E); }
            GSYNC();
            {
                PHASE_BEGIN;
                const bf16_t* CKR = WSP(bf16_t, WS_HB); bf16_t* CKVN = WSP(bf16_t, WS_CQN); bf16_t* KCAT = WSP(bf16_t, WS_KCAT); const float2* ROPE = WSP(float2, WS_ROPE);
                const f32x4 gg = *(const f32x4*)(INP(23) + 4 * lane);
                for (int m = gw; m < S_; m += ngw) {
                    const bf16_t* rp = CKR + (size_t)m * 512;
                    const u32x2 v = *(const u32x2*)(rp + 4 * lane);
                    const float a0 = bflo(v.x), a1 = bfhi(v.x), a2 = bflo(v.y), a3 = bfhi(v.y);
                    const float r = rsqrtf(wave_sum(a0 * a0 + a1 * a1 + a2 * a2 + a3 * a3) * (1.f / 256.f) + EPS);
                    u32x2 w; w.x = pk2(a0 * r * gg[0], a1 * r * gg[1]); w.y = pk2(a2 * r * gg[2], a3 * r * gg[3]);
                    *(u32x2*)(CKVN + (size_t)m * 256 + 4 * lane) = w;
                    if (lane < 32) {
                        const float x1 = bf2f(rp[256 + lane]), x2 = bf2f(rp[288 + lane]);
                        const float2 cs = ROPE[(size_t)m * 32 + lane];
                        const unsigned o = pk2(x1 * cs.x - x2 * cs.y, x1 * cs.y + x2 * cs.x);
#pragma unroll
                        for (int h = 0; h < 6; ++h) { bf16_t* kp = KCAT + ((size_t)h * S_ + m) * 192 + 128 + lane; kp[0] = (bf16_t)(o & 0xffffu); kp[32] = (bf16_t)(o >> 16); }
                    }
                }
            }
            GSYNC();
            { PHASE_BEGIN; EpiKnope E{WSP(bf16_t, WS_KCAT)}; run_gemm(L, WSP(bf16_t, WS_CQN), WSP(bf16_t, WS_UKT), S_, 768, 256, bx, E); }
            { PHASE_BEGIN; EpiStore<false> E{WSP(bf16_t, WS_VT), S_, nullptr}; run_gemm(L, WSP(bf16_t, WS_UVT), WSP(bf16_t, WS_CQN), 768, S_, 256, bx, E); }
            GSYNC();
        }
    }
    {
        PHASE_BEGIN;
        const float* g = INP(25); const bf16_t* XB = WSP(bf16_t, WS_XN);
        for (int m = gw; m < S_; m += ngw) {
            float* orow = p.out + (size_t)m * D_;
            f32x4 v[4]; float s = 0.f;
#pragma unroll
            for (int j = 0; j < 4; ++j) { const u32x2 w = *(const u32x2*)(XB + (size_t)m * D_ + 4 * lane + 256 * j);
                v[j] = (f32x4){bflo(w.x), bfhi(w.x), bflo(w.y), bfhi(w.y)}; s += (v[j][0] * v[j][0] + v[j][1] * v[j][1]) + (v[j][2] * v[j][2] + v[j][3] * v[j][3]); }
            const float r = rsqrtf(wave_sum(s) * (1.f / D_) + EPS);
#pragma unroll
            for (int j = 0; j < 4; ++j) { const f32x4 gg = *(const f32x4*)(g + 4 * lane + 256 * j); *(f32x4*)(orow + 4 * lane + 256 * j) = v[j] * r * gg; }
        }
    }
}

extern "C" void kernel_launch(void* const* d_in, const int* in_sizes, int n_in, void* d_out, int out_size, void* d_ws, size_t ws_size, hipStream_t stream) {
    static int grid_blocks = 0;
    if (grid_blocks == 0) {
        int dev = 0, cus = 0, per_cu = 0;
        hipGetDevice(&dev);
        hipDeviceGetAttribute(&cus, hipDeviceAttributeMultiprocessorCount, dev);
        hipFuncSetAttribute((const void*)fwd_megakernel, hipFuncAttributeMaxDynamicSharedMemorySize, LDS_BYTES);
        hipOccupancyMaxActiveBlocksPerMultiprocessor(&per_cu, (const void*)fwd_megakernel, NTHREADS, LDS_BYTES);
        if (per_cu < 1) per_cu = 1;
        grid_blocks = cus * per_cu;
        if (ws_size < WS_END) fprintf(stderr, "kernel_launch: workspace too small: %zu < %zu\n", ws_size, (size_t)WS_END);
    }
    (void)hipMemsetAsync((char*)d_ws + WS_CTL, 0, CTL_ZERO_BYTES, stream);
    Params p{};
    for (int i = 0; i < 26; ++i) p.in[i] = (const float*)d_in[i];
    p.out = (float*)d_out; p.ws = (unsigned char*)d_ws;
    for (int j = 0; j < 32; ++j) p.invf[j] = (float)pow(10000.0, -(double)(2 * j) / 64.0);
    void* args[] = {&p};
    hipError_t e = hipLaunchCooperativeKernel((const void*)fwd_megakernel, dim3(grid_blocks), dim3(NTHREADS), args, LDS_BYTES, stream);
    if (e != hipSuccess) fprintf(stderr, "cooperative launch failed: %s (grid %d)\n", hipGetErrorString(e), grid_blocks);
}
```
